# Optimizing an MI355X kernel written in HIP

```python
import jax, jax.numpy as jnp
from jax import lax
import numpy as np

D_MODEL = 1024
BATCH = 8
SEQ = 2048
DEPTH = 1
DEC_BATCH = 128
DEC_SEQ = 1
PAST_LEN = 16384
PAGE_SIZE = 128

D_CONV = D_MODEL // 2
CONV_W = 31
D_GMLP = D_MODEL // 2
GMLP_HEADS = 8
GMLP_HEAD_DIM = D_GMLP // GMLP_HEADS
CHUNK = 128
IN_W = 2 * D_CONV + 2 * D_GMLP + 2 * D_MODEL
PEER_HEADS = 8
N_KEYS = 128
N_EXPERTS = N_KEYS * N_KEYS
D_KEY = 256
TOPK = 16
PEER_BLOCK = 128
EPS = 1e-6

kernel_name = "hybrid_conv_gmlp_peer_adaln_step"


def rmsnorm(x, g):
    xf = x.astype(jnp.float32)
    y = xf * lax.rsqrt(jnp.mean(xf * xf, axis=-1, keepdims=True) + EPS)
    return (y * g.astype(jnp.float32)).astype(x.dtype)


def layernorm(x, g, b):
    xf = x.astype(jnp.float32)
    mu = jnp.mean(xf, axis=-1, keepdims=True)
    var = jnp.mean(jnp.square(xf - mu), axis=-1, keepdims=True)
    y = (xf - mu) * lax.rsqrt(var + EPS)
    return (y * g.astype(jnp.float32) + b.astype(jnp.float32)).astype(x.dtype)


def causal_dwconv(full, w, b):
    y = lax.conv_general_dilated(full, w[:, None, :], window_strides=(1,), padding="VALID",
                                 dimension_numbers=("NWC", "WIO", "NWC"),
                                 feature_group_count=full.shape[-1])
    return y + b


def chunk_spatial_gate(v, w_s, b_s):
    n, s, _ = v.shape
    L = min(CHUNK, s)
    vh = v.reshape(n, s // L, L, GMLP_HEADS, GMLP_HEAD_DIM)
    mask = jnp.tril(jnp.ones((L, L), dtype=bool))
    wm = jnp.where(mask[None], w_s[:, :L, :L], jnp.zeros((), w_s.dtype))
    sg = jnp.einsum("hij,ncjhd->ncihd", wm, vh) + b_s[:, :L].T[None, None, :, :, None]
    return sg.reshape(n, s, D_GMLP)


def peer_block(xb, w_q, k1, k2, u_tab, v_tab):
    tb = xb.shape[0]
    half = D_KEY // 2
    q = (xb @ w_q).reshape(tb, PEER_HEADS, D_KEY)
    s1 = jnp.einsum("thd,nd->thn", q[..., :half], k1)
    s2 = jnp.einsum("thd,nd->thn", q[..., half:], k2)
    sc1, i1 = lax.top_k(s1, TOPK)
    sc2, i2 = lax.top_k(s2, TOPK)
    cand = (sc1[..., :, None] + sc2[..., None, :]).reshape(tb, PEER_HEADS, TOPK * TOPK)
    cid = (i1[..., :, None] * N_KEYS + i2[..., None, :]).reshape(tb, PEER_HEADS, TOPK * TOPK)
    top, pos = lax.top_k(cand, TOPK)
    eid = jnp.take_along_axis(cid, pos, axis=-1).reshape(tb, PEER_HEADS * TOPK)
    g = jax.nn.softmax(top.astype(jnp.float32), axis=-1).astype(xb.dtype).reshape(tb, PEER_HEADS * TOPK)
    act = jax.nn.gelu(jnp.einsum("tnd,td->tn", u_tab[eid], xb), approximate=False)
    return jnp.einsum("tn,tnd->td", g * act, v_tab[eid])


def peer(xn, w_q, k1, k2, u_tab, v_tab):
    n, s, d = xn.shape
    tot = n * s
    nb = -(-tot // PEER_BLOCK)
    t = jnp.pad(xn.reshape(tot, d), ((0, nb * PEER_BLOCK - tot), (0, 0))).reshape(nb, PEER_BLOCK, d)
    out = lax.map(lambda xb: peer_block(xb, w_q, k1, k2, u_tab, v_tab), t)
    return out.reshape(nb * PEER_BLOCK, d)[:tot].reshape(n, s, d)


def layer(x, c, hist, w_ada, b_ada, g_mix, w_in, w_dw, b_dw, g_cn, b_cn, w_conv_out,
          g_v, b_v, w_s, b_s, w_gmlp_out, w_out, g_ffn, w_q, k1, k2, u_tab, v_tab):
    mod = jax.nn.silu(c) @ w_ada + b_ada
    sh1, sc1, gt1, sh2, sc2, gt2 = [m[:, None, :] for m in jnp.split(mod, 6, axis=-1)]
    n = rmsnorm(x, g_mix) * (1 + sc1) + sh1
    z = n @ w_in
    a_lin, a_gate, u, v, g_a, g_b = jnp.split(
        z, [D_CONV, 2 * D_CONV, 2 * D_CONV + D_GMLP, 2 * D_CONV + 2 * D_GMLP,
            2 * D_CONV + 2 * D_GMLP + D_MODEL], axis=-1)
    a = a_lin * jax.nn.sigmoid(a_gate)
    full = jnp.concatenate([hist, a], axis=1)
    new_hist = full[:, full.shape[1] - (CONV_W - 1):]
    a = jax.nn.silu(layernorm(causal_dwconv(full, w_dw, b_dw), g_cn, b_cn)) @ w_conv_out
    v = layernorm(v, g_v, b_v)
    b_br = (u * chunk_spatial_gate(v, w_s, b_s)) @ w_gmlp_out
    m = jax.nn.sigmoid(g_a) * a + jax.nn.sigmoid(g_b) * b_br
    x = x + gt1 * (m @ w_out)
    n2 = rmsnorm(x, g_ffn) * (1 + sc2) + sh2
    x = x + gt2 * peer(n2, w_q, k1, k2, u_tab, v_tab)
    return x, new_hist, v


def setup_inputs(seed: int = 0) -> dict:
    key = jax.random.key(seed)
    ks = jax.random.split(key, 32)

    def nrm(k, shape, scale):
        return scale * jax.random.normal(k, shape, jnp.float32)

    L = DEPTH
    return {
        "x_prompt": nrm(ks[0], (BATCH, SEQ, D_MODEL), 1.0),
        "x_sample": nrm(ks[1], (DEC_BATCH, DEC_SEQ, D_MODEL), 1.0),
        "state_conv": nrm(ks[2], (DEPTH, DEC_BATCH, CONV_W - 1, D_CONV), 0.5),
        "c_prompt": nrm(ks[3], (BATCH, D_MODEL), 1.0),
        "c_sample": nrm(ks[4], (DEC_BATCH, D_MODEL), 1.0),
        "w_ada": nrm(ks[5], (L, D_MODEL, 6 * D_MODEL), 0.5 * D_MODEL ** -0.5),
        "b_ada": nrm(ks[6], (L, 6 * D_MODEL), 0.02),
        "g_mix": 1.0 + nrm(ks[7], (L, D_MODEL), 0.05),
        "w_in": nrm(ks[8], (L, D_MODEL, IN_W), D_MODEL ** -0.5),
        "w_dw": nrm(ks[9], (L, CONV_W, D_CONV), CONV_W ** -0.5),
        "b_dw": nrm(ks[10], (L, D_CONV), 0.02),
        "g_cn": 1.0 + nrm(ks[11], (L, D_CONV), 0.05),
        "b_cn": nrm(ks[12], (L, D_CONV), 0.02),
        "w_conv_out": nrm(ks[13], (L, D_CONV, D_MODEL), D_CONV ** -0.5),
        "g_v": 1.0 + nrm(ks[14], (L, D_GMLP), 0.05),
        "b_v": nrm(ks[15], (L, D_GMLP), 0.02),
        "w_s": nrm(ks[16], (L, GMLP_HEADS, CHUNK, CHUNK), CHUNK ** -0.5),
        "b_s": 1.0 + nrm(ks[17], (L, GMLP_HEADS, CHUNK), 0.1),
        "w_gmlp_out": nrm(ks[18], (L, D_GMLP, D_MODEL), D_GMLP ** -0.5),
        "w_out": nrm(ks[19], (L, D_MODEL, D_MODEL), D_MODEL ** -0.5),
        "g_ffn": 1.0 + nrm(ks[20], (L, D_MODEL), 0.05),
        "w_q": nrm(ks[21], (L, D_MODEL, PEER_HEADS * D_KEY), D_MODEL ** -0.5),
        "k1": nrm(ks[22], (L, N_KEYS, D_KEY // 2), (D_KEY // 2) ** -0.5),
        "k2": nrm(ks[23], (L, N_KEYS, D_KEY // 2), (D_KEY // 2) ** -0.5),
        "u_tab": nrm(ks[24], (L, N_EXPERTS, D_MODEL), D_MODEL ** -0.5),
        "v_tab": nrm(ks[25], (L, N_EXPERTS, D_MODEL), (PEER_HEADS * TOPK) ** -0.5),
        "g_final": 1.0 + nrm(ks[26], (D_MODEL,), 0.05),
    }


def reference(x_prompt, x_sample, state_conv, c_prompt, c_sample, w_ada, b_ada, g_mix, w_in,
              w_dw, b_dw, g_cn, b_cn, w_conv_out, g_v, b_v, w_s, b_s, w_gmlp_out, w_out,
              g_ffn, w_q, k1, k2, u_tab, v_tab, g_final):
    hp, hs = x_prompt, x_sample
    hist_p, hist_s, v_s = [], [], []
    for l in range(DEPTH):
        lp = (w_ada[l], b_ada[l], g_mix[l], w_in[l], w_dw[l], b_dw[l], g_cn[l], b_cn[l],
              w_conv_out[l], g_v[l], b_v[l], w_s[l], b_s[l], w_gmlp_out[l], w_out[l],
              g_ffn[l], w_q[l], k1[l], k2[l], u_tab[l], v_tab[l])
        zero_hist = jnp.zeros((x_prompt.shape[0], CONV_W - 1, D_CONV), x_prompt.dtype)
        hp, hp_hist, _ = layer(hp, c_prompt, zero_hist, *lp)
        hs, hs_hist, hs_v = layer(hs, c_sample, state_conv[l], *lp)
        hist_p.append(hp_hist)
        hist_s.append(hs_hist)
        v_s.append(hs_v)
    y_prompt = rmsnorm(hp, g_final)
    y_sample = rmsnorm(hs, g_final)
    return (y_prompt, y_sample, jnp.stack(hist_p), jnp.stack(hist_s), jnp.stack(v_s))
```

```cpp
#include <hip/hip_runtime.h>
#include <hip/hip_cooperative_groups.h>
#include <cstdio>
#include <cstdint>
namespace cg = cooperative_groups;
namespace pg8 {
#define PG8_LAS __attribute__((address_space(3)))
typedef unsigned short bf16_t;
typedef short bf16x8 __attribute__((ext_vector_type(8)));
typedef float f32x4 __attribute__((ext_vector_type(4)));
typedef unsigned u32x4 __attribute__((ext_vector_type(4)));
constexpr int BM = 256, BK = 64, HALF = 128, HTB = HALF * BK * 2  , STAGE_BYTES = 8 * HTB, NXCD = 8, WGM = 8;

__host__ __device__ __forceinline__ int lds_byte(int r, int c) { const int st = (r >> 4) * 2 + (c >> 5), rr = r & 15, cc = c & 31, ob = rr * 64 + cc * 2; return st * 1024 + (ob ^ (((ob >> 9) & 1) << 5)); }
__host__ __device__ __forceinline__ void stage_rc(int b, int& R, int& C) { const int st = b / 1024, sb = b % 1024, swz = sb ^ (((sb >> 9) & 1) << 5); R = (st >> 1) * 16 + swz / 64; C = (st & 1) * 32 + (swz % 64) / 2; }
__host__ __device__ __forceinline__ int perm32(int rho) { const int n = rho >> 4, i = rho & 15; return 8 * (i >> 2) + 4 * n + (i & 3); }

struct Unit { int pm, pn, kh; };
struct Gemm { const bf16_t* A; const bf16_t* Bt; int M, N, K, lda, ldb; size_t a_tile, b_tile, b_pm; };
__host__ __device__ __forceinline__ Gemm mk_gemm(const bf16_t* A, const bf16_t* Bt, int M, int N, int K, int ld) { Gemm g; g.A = A; g.Bt = Bt; g.M = M; g.N = N; g.K = K; g.lda = ld; g.ldb = ld; g.a_tile = (size_t)256 * ld * 2; g.b_tile = (size_t)256 * ld * 2; g.b_pm = 0; return g; }

struct StaticOrder {
    int nM, nN, nwg, G, c;
    __host__ __device__ void init(int M, int N, int G_, int c_) { nM = M / BM; nN = N / BM; nwg = nM * nN; G = G_; c = c_; }
    __host__ __device__ bool next(int i, Unit& u) const {
        const long L = (long)i * G + c; if (L >= nwg) return false;
        int wgid = (int)L; { const int q = nwg / NXCD, r = nwg % NXCD, xcd = wgid % NXCD, off = wgid / NXCD; wgid = (xcd < r ? xcd * (q + 1) : r * (q + 1) + (xcd - r) * q) + off; }
        const int nig = WGM * nN, gid = wgid / nig, fm = gid * WGM, gsz = (nM - fm) < WGM ? (nM - fm) : WGM;
        u.pm = fm + ((wgid % nig) % gsz); u.pn = (wgid % nig) / gsz; u.kh = 0; return true;
    }
    __device__ __forceinline__ void a_ready(const Unit&) const {}
    __device__ __forceinline__ void done(const Unit&) const {}
};
struct SplitOrder : StaticOrder {
    __host__ __device__ bool next(int i, Unit& u) const { if (!StaticOrder::next(i >> 1, u)) return false; u.kh = i & 1; return true; }
};
struct KSplitOrder { int nN, ns, G, c;
    __host__ __device__ void init(int N, int nsplit, int G_, int c_) { nN = N / BM; ns = nsplit; G = G_; c = c_; }
    __host__ __device__ bool next(int i, Unit& u) const { const long L = (long)i * G + c; if (L >= (long)nN * ns) return false; u.pm = 0; u.pn = (int)(L / ns); u.kh = (int)(L % ns); return true; }
    __device__ __forceinline__ void a_ready(const Unit&) const {}
    __device__ __forceinline__ void done(const Unit&) const {}
};
__device__ __forceinline__ unsigned cvt_pk_bf16(float lo, float hi) { unsigned r; asm volatile("v_cvt_pk_bf16_f32 %0, %1, %2" : "=v"(r) : "v"(lo), "v"(hi)); return r; }
template <class Epi, class Sched>
__device__ __forceinline__ void gemm_phase(PG8_LAS unsigned char* lds, const Gemm g, const Sched& S, const Epi& E) {
    const int tid = threadIdx.x, wid = __builtin_amdgcn_readfirstlane(tid >> 6), lane = tid & 63, wr = wid >> 2, wc = wid & 3, fr = lane & 15, fq = lane >> 4;
    const int K = g.K, LDA = g.lda, LDB = g.ldb, nt = K / BK;
    unsigned voffA[2], voffB[2];
#pragma unroll
    for (int i = 0; i < 2; ++i) { int R, C; stage_rc(tid * 16 + i * 8192, R, C); const int Rb = Epi::PERM ? ((R & ~31) + perm32(R & 31)) : R;
        voffA[i] = (unsigned)(R * LDA + C) * 2u; voffB[i] = (unsigned)(Rb * LDB + C) * 2u; }
    const size_t kstep = (size_t)(BK * 2);
    const size_t hstepA = (size_t)HALF * LDA * 2, hstepB = (size_t)HALF * LDB * 2;
    const size_t tA = g.a_tile, tB = g.b_tile, tBm = g.b_pm;
    const unsigned ldsw = (unsigned)wid * 1024u;
    const int aoff = lds_byte(wr * 64 + fr, fq * 8), boff = lds_byte(wc * 32 + fr, fq * 8);
#define PG8_SA(b, h) (((b) * 2 + (h)) * HTB)
#define PG8_SB(b, h) ((4 + (b) * 2 + (h)) * HTB)
#define PG8_STAGE(bufoff, gbase, voff) do { _Pragma("unroll") for (int _i = 0; _i < 2; ++_i) \
        __builtin_amdgcn_global_load_lds((const unsigned*)((const char*)(gbase) + (voff)[_i]), (PG8_LAS unsigned*)(lds + (bufoff) + ldsw + _i * 8192), 16, 0, 0); } while (0)
#define PG8_LDA(dst, b, h) do { _Pragma("unroll") for (int m = 0; m < 4; ++m) _Pragma("unroll") for (int k = 0; k < 2; ++k) dst[m][k] = *(const PG8_LAS bf16x8*)(lds + PG8_SA(b, h) + aoff + m * 2048 + k * 1024); } while (0)
#define PG8_LDB(dst, b, h) do { _Pragma("unroll") for (int n = 0; n < 2; ++n) _Pragma("unroll") for (int k = 0; k < 2; ++k) dst[n][k] = *(const PG8_LAS bf16x8*)(lds + PG8_SB(b, h) + boff + n * 2048 + k * 1024); } while (0)
#define PG8_MMA(ai, bj, At, Bt) do { __builtin_amdgcn_s_setprio(1); _Pragma("unroll") for (int m = 0; m < 4; ++m) _Pragma("unroll") for (int n = 0; n < 2; ++n) _Pragma("unroll") for (int k = 0; k < 2; ++k) \
        acc[ai][bj][m][n] = __builtin_amdgcn_mfma_f32_16x16x32_bf16(Bt[n][k], At[m][k], acc[ai][bj][m][n], 0, 0, 0); __builtin_amdgcn_s_setprio(0); } while (0)
#define PG8_WAIT_V(n) asm volatile("s_waitcnt vmcnt(" #n ")" ::: "memory")
#define PG8_WAIT_L(n) asm volatile("s_waitcnt lgkmcnt(" #n ")" ::: "memory")
#define PG8_BAR __builtin_amdgcn_s_barrier()
#define PG8_SCHED __builtin_amdgcn_sched_barrier(0)
    Unit cur, nxt; int ui = 0;
    if (!S.next(0, cur)) return;
    f32x4 acc[2][2][4][2];
#pragma unroll
    for (int a = 0; a < 2; ++a)
#pragma unroll
        for (int b = 0; b < 2; ++b)
#pragma unroll
            for (int m = 0; m < 4; ++m)
#pragma unroll
                for (int n = 0; n < 2; ++n) acc[a][b][m][n] = (f32x4){0.f, 0.f, 0.f, 0.f};
    bf16x8 At[4][2], B0[2][2], B1[2][2];
    const char* cA = (const char*)g.A + (size_t)cur.pm * tA + (size_t)cur.kh * K * 2; const char* cB = (const char*)g.Bt + (size_t)cur.pn * tB + (size_t)cur.pm * tBm + (size_t)cur.kh * K * 2;
    S.a_ready(cur);
    PG8_STAGE(PG8_SB(0, 0), cB, voffB); PG8_STAGE(PG8_SA(0, 0), cA, voffA); PG8_STAGE(PG8_SB(0, 1), cB + hstepB, voffB); PG8_STAGE(PG8_SA(0, 1), cA + hstepA, voffA);
    if (wr == 1) PG8_BAR;
    PG8_WAIT_V(4); PG8_BAR;
    PG8_STAGE(PG8_SB(1, 0), cB + kstep, voffB); PG8_STAGE(PG8_SA(1, 0), cA + kstep, voffA); PG8_STAGE(PG8_SB(1, 1), cB + hstepB + kstep, voffB);
    PG8_WAIT_V(6); PG8_BAR;
    for (;;) {
        const bool has_next = S.next(ui + 1, nxt);
        const char* nA = has_next ? (const char*)g.A + (size_t)nxt.pm * tA + (size_t)nxt.kh * K * 2 : cA; const char* nB = has_next ? (const char*)g.Bt + (size_t)nxt.pn * tB + (size_t)nxt.pm * tBm + (size_t)nxt.kh * K * 2 : cB;
        for (int t = 0; t < nt; t += 2) {
            const bool last = (t == nt - 2);
            const char* a1 = cA + (size_t)(t + 1) * kstep;
            const char* a2 = last ? nA : cA + (size_t)(t + 2) * kstep; const char* b2 = last ? nB : cB + (size_t)(t + 2) * kstep;
            const char* a3 = a2 + kstep; const char* b3 = b2 + kstep;
            if (last && has_next) S.a_ready(nxt);
            PG8_LDB(B0, 0, 0); PG8_SCHED; PG8_LDA(At, 0, 0); PG8_STAGE(PG8_SA(1, 1), a1 + hstepA, voffA);
            PG8_WAIT_L(8); PG8_BAR; PG8_WAIT_L(0); PG8_MMA(0, 0, At, B0); PG8_BAR; PG8_SCHED;
            PG8_LDB(B1, 0, 1); PG8_STAGE(PG8_SB(0, 0), b2, voffB);
            PG8_BAR; PG8_WAIT_L(0); PG8_MMA(0, 1, At, B1); PG8_BAR;
            PG8_LDA(At, 0, 1); PG8_STAGE(PG8_SA(0, 0), a2, voffA);
            PG8_BAR; PG8_WAIT_L(0); PG8_MMA(1, 0, At, B0); PG8_BAR; PG8_SCHED;
            PG8_STAGE(PG8_SB(0, 1), b2 + hstepB, voffB);
            PG8_WAIT_V(6); PG8_BAR; PG8_MMA(1, 1, At, B1); PG8_BAR;
            PG8_LDB(B0, 1, 0); PG8_SCHED; PG8_LDA(At, 1, 0); PG8_STAGE(PG8_SA(0, 1), a2 + hstepA, voffA);
            PG8_WAIT_L(8); PG8_BAR; PG8_WAIT_L(0); PG8_MMA(0, 0, At, B0); PG8_BAR; PG8_SCHED;
            PG8_LDB(B1, 1, 1); PG8_STAGE(PG8_SB(1, 0), b3, voffB);
            PG8_BAR; PG8_WAIT_L(0); PG8_MMA(0, 1, At, B1); PG8_BAR;
            PG8_LDA(At, 1, 1); PG8_STAGE(PG8_SA(1, 0), a3, voffA);
            PG8_BAR; PG8_WAIT_L(0); PG8_MMA(1, 0, At, B0); PG8_BAR; PG8_SCHED;
            PG8_STAGE(PG8_SB(1, 1), b3 + hstepB, voffB);
            PG8_WAIT_V(6); PG8_BAR; PG8_MMA(1, 1, At, B1); PG8_BAR;
        }
        if (wr == 0) PG8_BAR;
        if constexpr (Epi::HAS_MID) { if (cur.kh == 0) E.mid(acc, cur, wr, wc, fr, fq); else E(acc, cur, wr, wc, fr, fq); } else E(acc, cur, wr, wc, fr, fq);
        if (!has_next) break;
        if (!(Epi::HAS_MID && nxt.kh == 1)) {
#pragma unroll
        for (int a = 0; a < 2; ++a)
#pragma unroll
            for (int b = 0; b < 2; ++b)
#pragma unroll
                for (int m = 0; m < 4; ++m)
#pragma unroll
                    for (int n = 0; n < 2; ++n) acc[a][b][m][n] = (f32x4){0.f, 0.f, 0.f, 0.f};
        }
        cur = nxt; cA = nA; cB = nB; ++ui;
        if (wr == 1) PG8_BAR;
    }
    PG8_WAIT_V(0);
    PG8_BAR;
#undef PG8_SA
#undef PG8_SB
#undef PG8_STAGE
#undef PG8_LDA
#undef PG8_LDB
#undef PG8_MMA
#undef PG8_WAIT_V
#undef PG8_WAIT_L
#undef PG8_BAR
#undef PG8_SCHED
}
}

using pg8::f32x4; using pg8::u32x4; using pg8::bf16x8; using pg8::bf16_t; using pg8::cvt_pk_bf16; using pg8::Unit;
#define LAS __attribute__((address_space(3)))
typedef unsigned u32x2 __attribute__((ext_vector_type(2)));
typedef int i32x4 __attribute__((ext_vector_type(4)));

constexpr int T_P = 16384, T_ALL = 16512, MP = 16640, DM = 1024, MODW = 6144;
constexpr float EPS = 1e-6f;
constexpr size_t KiB = 1024, MiB = 1024 * 1024;
constexpr size_t WS_MOD = 1 * MiB, WS_CS = 4608 * KiB, WS_KBLK = 5 * MiB, WS_WINT = 6 * MiB, WS_WCGT = 14 * MiB, WS_WOUTT = 16 * MiB, WS_WQT = 18 * MiB,
    WS_R1 = 22 * MiB, WS_R2 = WS_R1 + 33280 * KiB, WS_R3 = WS_R2 + 66560 * KiB, WS_R4 = WS_R3 + 33280 * KiB, WS_R5 = WS_R4 + 16640 * KiB, WS_END = WS_R3 + 133120 * KiB;
constexpr size_t OUT_YS = (size_t)T_P * DM, OUT_CSP = OUT_YS + 128 * 1024, OUT_CSS = OUT_CSP + 8 * 30 * 512, OUT_GV = OUT_CSS + 128 * 30 * 512;
constexpr int LDS_MAIN = 512 * 136 * 2, LDS_BYTES = LDS_MAIN + 16;
constexpr int NPH = 15;
constexpr size_t MODP_STRIDE = (size_t)136 * 6144;
constexpr size_t WS_CNT2 = 16384, WS_CTL_BYTES = 16384 + 8 * 256, WS_EID = 6 * MiB, WS_GATE = 11 * MiB, WS_PART = WS_R3, WS_SUMSQ = WS_R3 + 66 * MiB, WS_CF = WS_R3 + 68 * MiB, WS_WQN = WS_R3 + 12 * MiB, WS_MODP = WS_R2;
#ifndef PH_MASK
#define PH_MASK 0x7FFF
#endif
#define PHON(k) (((PH_MASK) >> (k)) & 1)
#ifndef REPEAT_MASK
#define REPEAT_MASK 0
#endif
#define REPS(k) (1 + (((REPEAT_MASK) >> (k)) & 1))

enum { I_x_prompt = 0, I_x_sample = 1, I_state_conv = 2, I_c_prompt = 3, I_c_sample = 4, I_w_ada = 5, I_b_ada = 6, I_g_mix = 7, I_w_in = 8, I_w_dw = 9, I_b_dw = 10, I_g_cn = 11, I_b_cn = 12, I_w_conv_out = 13, I_g_v = 14, I_b_v = 15, I_w_s = 16, I_b_s = 17, I_w_gmlp_out = 18, I_w_out = 19, I_g_ffn = 20, I_w_q = 21, I_k1 = 22, I_k2 = 23, I_u_tab = 24, I_v_tab = 25, I_g_final = 26 };
struct Params { const float* in[27]; float* out; unsigned char* ws; int ph_lo, ph_hi; };
template <int I> __device__ __forceinline__ const float* ldarg() { const char* ka = (const char*)__builtin_amdgcn_kernarg_segment_ptr(); unsigned long long p;
    asm volatile("s_load_dwordx2 %0, %1, %2\n\ts_waitcnt lgkmcnt(0)" : "=s"(p) : "s"(ka), "i"(I * 8)); return (const float*)p; }
#define ARG(name) ldarg<I_##name>()


__device__ __forceinline__ float wave_sum(float v) {
#pragma unroll
    for (int o = 1; o < 64; o <<= 1) v += __shfl_xor(v, o);
    return v;
}
__device__ __forceinline__ float sigm(float x) { return 1.0f / (1.0f + __expf(-x)); }
__device__ __forceinline__ float bf_lo(unsigned w) { return __uint_as_float(w << 16); }
__device__ __forceinline__ float bf_hi(unsigned w) { return __uint_as_float(w & 0xffff0000u); }
__device__ __forceinline__ u32x4 pack8(f32x4 a, f32x4 b) { u32x4 w; w.x = cvt_pk_bf16(a[0], a[1]); w.y = cvt_pk_bf16(a[2], a[3]); w.z = cvt_pk_bf16(b[0], b[1]); w.w = cvt_pk_bf16(b[2], b[3]); return w; }
__device__ __forceinline__ int modrow(int r) { return r < T_P ? (r >> 11) : (8 + r - T_P); }
#define LDS_WAIT() asm volatile("s_waitcnt lgkmcnt(0)" ::: "memory")

struct EpiMod {
    static constexpr bool PERM = false, AFTER_DRAIN = false, HAS_MID = false;
    float* mod; const float* bias;
    __device__ __forceinline__ void operator()(const f32x4 (&acc)[2][2][4][2], const Unit& u, int wr, int wc, int fr, int fq) const {
        const int row0 = u.pm * 256 + wr * 64 + fr, col0 = u.pn * 256 + wc * 32 + 4 * fq;
#pragma unroll
        for (int ai = 0; ai < 2; ++ai)
#pragma unroll
            for (int m = 0; m < 4; ++m) { const int r = row0 + ai * 128 + m * 16;
                if (r < 136) {
#pragma unroll
                    for (int bj = 0; bj < 2; ++bj)
#pragma unroll
                        for (int n = 0; n < 2; ++n) { const int c = col0 + bj * 128 + n * 16; *(f32x4*)(mod + (size_t)u.kh * MODP_STRIDE + (size_t)r * MODW + c) = acc[ai][bj][m][n]; } } }
    }
};
struct EpiZ {
    static constexpr bool PERM = true, AFTER_DRAIN = false, HAS_MID = false;
    float* a_buf; bf16_t* u_buf; float* v_buf; bf16_t* ga; bf16_t* gb;
    __device__ __forceinline__ void operator()(const f32x4 (&acc)[2][2][4][2], const Unit& u, int wr, int wc, int fr, int fq) const {
        const int row0 = u.pm * 256 + wr * 64 + fr, cw = wc * 32 + 8 * fq, pn = u.pn;
        if (pn < 4) {
#pragma unroll
            for (int ai = 0; ai < 2; ++ai)
#pragma unroll
                for (int m = 0; m < 4; ++m) { const size_t r = row0 + ai * 128 + m * 16; float* dst = a_buf + r * 512 + pn * 128 + cw;
#pragma unroll
                    for (int n = 0; n < 2; ++n) { const f32x4 l = acc[ai][0][m][n], g = acc[ai][1][m][n]; f32x4 o;
#pragma unroll
                        for (int j = 0; j < 4; ++j) o[j] = l[j] * sigm(g[j]);
                        *(f32x4*)(dst + 4 * n) = o; } }
        } else if (pn < 6) {
#pragma unroll
            for (int ai = 0; ai < 2; ++ai)
#pragma unroll
                for (int m = 0; m < 4; ++m) { const size_t r = row0 + ai * 128 + m * 16;
#pragma unroll
                    for (int bj = 0; bj < 2; ++bj) *(u32x4*)(u_buf + r * 512 + (pn - 4) * 256 + bj * 128 + cw) = pack8(acc[ai][bj][m][0], acc[ai][bj][m][1]); }
        } else if (pn < 8) {
#pragma unroll
            for (int ai = 0; ai < 2; ++ai)
#pragma unroll
                for (int m = 0; m < 4; ++m) { const size_t r = row0 + ai * 128 + m * 16;
#pragma unroll
                    for (int bj = 0; bj < 2; ++bj) { float* dst = v_buf + r * 512 + (pn - 6) * 256 + bj * 128 + cw; *(f32x4*)dst = acc[ai][bj][m][0]; *(f32x4*)(dst + 4) = acc[ai][bj][m][1]; } }
        } else {
            bf16_t* gdst = pn < 12 ? ga : gb; const int cb = ((pn - 8) & 3) * 256;
#pragma unroll
            for (int ai = 0; ai < 2; ++ai)
#pragma unroll
                for (int m = 0; m < 4; ++m) { const size_t r = row0 + ai * 128 + m * 16;
#pragma unroll
                    for (int bj = 0; bj < 2; ++bj) { f32x4 s0, s1;
#pragma unroll
                        for (int j = 0; j < 4; ++j) { s0[j] = sigm(acc[ai][bj][m][0][j]); s1[j] = sigm(acc[ai][bj][m][1][j]); }
                        *(u32x4*)(gdst + r * 1024 + cb + bj * 128 + cw) = pack8(s0, s1); } }
        }
    }
};
struct EpiM {
    static constexpr bool PERM = true, AFTER_DRAIN = false, HAS_MID = true;
    const bf16_t* ga; const bf16_t* gb; bf16_t* m_buf;
    __device__ __forceinline__ void mid(f32x4 (&acc)[2][2][4][2], const Unit& u, int wr, int wc, int fr, int fq) const {
        const int row0 = u.pm * 256 + wr * 64 + fr, cw = wc * 32 + 8 * fq;
#pragma unroll
        for (int ai = 0; ai < 2; ++ai)
#pragma unroll
            for (int m = 0; m < 4; ++m) { const size_t r = row0 + ai * 128 + m * 16;
#pragma unroll
                for (int bj = 0; bj < 2; ++bj) { const size_t o = r * 1024 + u.pn * 256 + bj * 128 + cw; const u32x4 A = *(const u32x4*)(ga + o), B = *(const u32x4*)(gb + o);
#pragma unroll
                    for (int w = 0; w < 4; ++w) { const float rl = bf_lo(A[w]) * __builtin_amdgcn_rcpf(fmaxf(bf_lo(B[w]), 1e-30f)), rh = bf_hi(A[w]) * __builtin_amdgcn_rcpf(fmaxf(bf_hi(B[w]), 1e-30f));
                        acc[ai][bj][m][w >> 1][(w & 1) * 2] *= rl; acc[ai][bj][m][w >> 1][(w & 1) * 2 + 1] *= rh; } }
                asm volatile("" : "+v"(acc[ai][0][m][0]), "+v"(acc[ai][0][m][1]), "+v"(acc[ai][1][m][0]), "+v"(acc[ai][1][m][1]));
                asm volatile("" ::: "memory"); }
    }
    __device__ __forceinline__ void operator()(const f32x4 (&acc)[2][2][4][2], const Unit& u, int wr, int wc, int fr, int fq) const {
        const int row0 = u.pm * 256 + wr * 64 + fr, cw = wc * 32 + 8 * fq;
#pragma unroll
        for (int ai = 0; ai < 2; ++ai)
#pragma unroll
            for (int m = 0; m < 4; ++m) { const size_t r = row0 + ai * 128 + m * 16;
#pragma unroll
                for (int bj = 0; bj < 2; ++bj) { const size_t o = r * 1024 + u.pn * 256 + bj * 128 + cw; const u32x4 B = *(const u32x4*)(gb + o); f32x4 v0 = acc[ai][bj][m][0], v1 = acc[ai][bj][m][1];
                    v0[0] *= bf_lo(B[0]); v0[1] *= bf_hi(B[0]); v0[2] *= bf_lo(B[1]); v0[3] *= bf_hi(B[1]); v1[0] *= bf_lo(B[2]); v1[1] *= bf_hi(B[2]); v1[2] *= bf_lo(B[3]); v1[3] *= bf_hi(B[3]);
                    *(u32x4*)(m_buf + o) = pack8(v0, v1); } }
    }
};
struct EpiX1 {
    static constexpr bool PERM = false, AFTER_DRAIN = false, HAS_MID = false;
    const float* xp; const float* xs; const float* mod; float* out;
    __device__ __forceinline__ void operator()(const f32x4 (&acc)[2][2][4][2], const Unit& u, int wr, int wc, int fr, int fq) const {
        const int row0 = u.pm * 256 + wr * 64 + fr, col0 = u.pn * 256 + wc * 32 + 4 * fq;
#pragma unroll
        for (int ai = 0; ai < 2; ++ai)
#pragma unroll
            for (int m = 0; m < 4; ++m) { const int r = row0 + ai * 128 + m * 16;
                if (r < T_ALL) { const float* xr = r < T_P ? xp + (size_t)r * DM : xs + (size_t)(r - T_P) * DM; const float* gt = mod + (size_t)modrow(r) * MODW + 2048; float* o = out + (size_t)r * DM;
#pragma unroll
                    for (int bj = 0; bj < 2; ++bj)
#pragma unroll
                        for (int n = 0; n < 2; ++n) { const int c = col0 + bj * 128 + n * 16; *(f32x4*)(o + c) = *(const f32x4*)(xr + c) + *(const f32x4*)(gt + c) * acc[ai][bj][m][n]; } } }
    }
};
struct EpiQ {
    static constexpr bool PERM = true, AFTER_DRAIN = false, HAS_MID = false;
    bf16_t* q;
    __device__ __forceinline__ void operator()(const f32x4 (&acc)[2][2][4][2], const Unit& u, int wr, int wc, int fr, int fq) const {
        const int row0 = u.pm * 256 + wr * 64 + fr, cw = wc * 32 + 8 * fq;
#pragma unroll
        for (int ai = 0; ai < 2; ++ai)
#pragma unroll
            for (int m = 0; m < 4; ++m) { const size_t r = row0 + ai * 128 + m * 16;
#pragma unroll
                for (int bj = 0; bj < 2; ++bj) *(u32x4*)(q + r * 2048 + u.pn * 256 + bj * 128 + cw) = pack8(acc[ai][bj][m][0], acc[ai][bj][m][1]); }
    }
};
struct EpiS {
    static constexpr bool PERM = false, AFTER_DRAIN = false, HAS_MID = false;
    float* sc;
    __device__ __forceinline__ void operator()(const f32x4 (&acc)[2][2][4][2], const Unit& u, int wr, int wc, int fr, int fq) const {
        const int row0 = u.pm * 256 + wr * 64 + fr, col0 = wc * 32 + 4 * fq;
#pragma unroll
        for (int ai = 0; ai < 2; ++ai)
#pragma unroll
            for (int m = 0; m < 4; ++m) { const size_t r = row0 + ai * 128 + m * 16;
#pragma unroll
                for (int bj = 0; bj < 2; ++bj)
#pragma unroll
                    for (int n = 0; n < 2; ++n) *(f32x4*)(sc + (r >> 5) * 8192 + (size_t)((col0 + n * 16) >> 2) * 256 + (bj * 32 + (r & 31)) * 4) = acc[ai][bj][m][n]; }
    }
};

struct EpiW {
    static constexpr bool PERM = true, AFTER_DRAIN = false, HAS_MID = false;
    bf16_t* w;
    __device__ __forceinline__ void operator()(const f32x4 (&acc)[2][2][4][2], const Unit& u, int wr, int wc, int fr, int fq) const {
        const int row0 = u.pm * 256 + wr * 64 + fr, cw = wc * 32 + 8 * fq;
#pragma unroll
        for (int ai = 0; ai < 2; ++ai)
#pragma unroll
            for (int m = 0; m < 4; ++m) { const size_t r = row0 + ai * 128 + m * 16;
#pragma unroll
                for (int bj = 0; bj < 2; ++bj) *(u32x4*)(w + r * 1024 + u.pn * 256 + bj * 128 + cw) = pack8(acc[ai][bj][m][0], acc[ai][bj][m][1]); }
    }
};
struct EpiS2 {
    static constexpr bool PERM = false, AFTER_DRAIN = false, HAS_MID = false;
    float* sc;
    __device__ __forceinline__ void operator()(const f32x4 (&acc)[2][2][4][2], const Unit& u, int wr, int wc, int fr, int fq) const {
        float* base = sc + (size_t)(u.pm * 8 + u.pn) * 65536; const int tl0 = wr * 64 + fr, j0 = wc * 32 + 4 * fq;
#pragma unroll
        for (int ai = 0; ai < 2; ++ai)
#pragma unroll
            for (int m = 0; m < 4; ++m) { const int tl = tl0 + ai * 128 + m * 16;
#pragma unroll
                for (int bj = 0; bj < 2; ++bj)
#pragma unroll
                    for (int n = 0; n < 2; ++n) __builtin_nontemporal_store(acc[ai][bj][m][n], (f32x4*)(base + (size_t)((j0 + n * 16) >> 2) * 2048 + bj * 1024 + tl * 4)); }
    }
};
__device__ __forceinline__ int winmap(int n) { if (n < 512) return ((n >> 7) << 8) + (n & 127); if (n < 1024) { const int ch = n - 512; return ((ch >> 7) << 8) + 128 + (ch & 127); } return n; }
__device__ __forceinline__ void transpose_item(const float* __restrict__ W, int N, bf16_t* WT, int ldt, int koff, bool remap, LAS float* scr, int item, int lane) {
    const int nblk = N >> 5, kb = item / nblk, nb = item - kb * nblk, k0 = 64 * kb, n0 = 32 * nb;
#pragma unroll 16
    for (int i = 0; i < 32; ++i) { const int kk = 2 * i + (lane >> 5); scr[kk * 33 + (lane & 31)] = __builtin_nontemporal_load(W + (size_t)(k0 + kk) * N + n0 + (lane & 31)); }
    LDS_WAIT();
    const int c = lane & 7;
#pragma unroll
    for (int j = 0; j < 4; ++j) { const int n = (lane >> 3) + 8 * j; const LAS float* s = scr + (8 * c) * 33 + n;
        u32x4 o; o.x = cvt_pk_bf16(s[0 * 33], s[1 * 33]); o.y = cvt_pk_bf16(s[2 * 33], s[3 * 33]); o.z = cvt_pk_bf16(s[4 * 33], s[5 * 33]); o.w = cvt_pk_bf16(s[6 * 33], s[7 * 33]);
        int nd = n0 + n; if (remap) nd = winmap(nd);
        *(u32x4*)(WT + (size_t)nd * ldt + koff + k0 + 8 * c) = o; }
    LDS_WAIT();
}
template <int PART> __device__ __forceinline__ void phase0(const Params& P, PG8_LAS unsigned char* lds, int lane, int wave, int gw, int NGW) {
    LAS float* scr = (LAS float*)(lds + wave * 8704);
    unsigned char* ws = P.ws;
    constexpr int I_ADA = 16 * 192, I_IN = 16 * 128, I_CO = 8 * 32, I_GO = 8 * 32, I_OUT = 16 * 32, I_Q = 16 * 64, I_KB = 256, I_CS = 256;
    if constexpr (PART == 0) {
        constexpr int I_QN = 1024;
        for (int it = gw; it < I_ADA + I_KB + I_CS + I_QN; it += NGW) {
            int r = it;
            if (r < I_ADA) { transpose_item(ARG(w_ada), MODW, (bf16_t*)(ws + WS_R3), 1024, 0, false, scr, r, lane); continue; } r -= I_ADA;
            if (r < I_KB) {
                const int n = r, c0 = 4 * lane; f32x4 v = (f32x4){0.f, 0.f, 0.f, 0.f};
                if (n < 128 && c0 < 128) v = *(const f32x4*)(ARG(k1) + n * 128 + c0);
                if (n >= 128 && c0 >= 128) v = *(const f32x4*)(ARG(k2) + (n - 128) * 128 + c0 - 128);
                u32x2 o; o.x = cvt_pk_bf16(v[0], v[1]); o.y = cvt_pk_bf16(v[2], v[3]);
                *(u32x2*)((bf16_t*)(ws + WS_KBLK) + n * 256 + c0) = o; continue; } r -= I_KB;
            if (r >= I_CS) { r -= I_CS; const float* src = ARG(w_q) + (size_t)r * 2048; bf16_t* dst = (bf16_t*)(ws + WS_WQN) + (size_t)r * 2048;
#pragma unroll
                for (int j = 0; j < 8; ++j) { const f32x4 v = *(const f32x4*)(src + 4 * lane + 256 * j); u32x2 o; o.x = cvt_pk_bf16(v[0], v[1]); o.y = cvt_pk_bf16(v[2], v[3]); *(u32x2*)(dst + 4 * lane + 256 * j) = o; }
                continue; }
            {
                const float* src = r < 8 ? ARG(c_prompt) + (size_t)r * DM : (r < 136 ? ARG(c_sample) + (size_t)(r - 8) * DM : nullptr);
#pragma unroll
                for (int j = 0; j < 4; ++j) { const int c0 = 4 * lane + 256 * j; f32x4 v = (f32x4){0.f, 0.f, 0.f, 0.f};
                    if (src) { v = *(const f32x4*)(src + c0);
#pragma unroll
                        for (int e = 0; e < 4; ++e) v[e] = v[e] * sigm(v[e]); }
                    u32x2 o; o.x = cvt_pk_bf16(v[0], v[1]); o.y = cvt_pk_bf16(v[2], v[3]);
                    *(u32x2*)((bf16_t*)(ws + WS_CS) + (size_t)r * DM + c0) = o; }
            }
        }
    } else {
        for (int it = gw; it < I_IN + I_CO + I_GO + I_OUT; it += NGW) {
            int r = it;
            if (r < I_IN) { transpose_item(ARG(w_in), 4096, (bf16_t*)(ws + WS_WINT), 1024, 0, true, scr, r, lane); continue; } r -= I_IN;
            if (r < I_CO) { transpose_item(ARG(w_conv_out), 1024, (bf16_t*)(ws + WS_WCGT), 1024, 0, false, scr, r, lane); continue; } r -= I_CO;
            if (r < I_GO) { transpose_item(ARG(w_gmlp_out), 1024, (bf16_t*)(ws + WS_WCGT), 1024, 512, false, scr, r, lane); continue; } r -= I_GO;
            transpose_item(ARG(w_out), 1024, (bf16_t*)(ws + WS_WOUTT), 1024, 0, false, scr, r, lane);
        }
    }
}
struct WaveItems { int q, extra, stride, nk; int gw, NGW;
    __device__ __forceinline__ WaveItems(int NIT, int gw_, int NGW_) : gw(gw_), NGW(NGW_) { q = NIT / NGW_; extra = NIT - q * NGW_; stride = extra ? NGW_ / extra : 1; nk = q + ((extra && gw_ % stride == 0 && gw_ / stride < extra) ? 1 : 0); }
    __device__ __forceinline__ int item(int k) const { return k < q ? gw + k * NGW : q * NGW + gw / stride; } };
template <bool SECOND> __device__ __forceinline__ void norm_rows(const Params& P, bf16_t* dst, int lane, int gw, int NGW) {
    const float* mod = SECOND ? (const float*)(P.ws + WS_MOD) : (const float*)(P.ws + WS_MODP); const float* bada = ARG(b_ada);
    const float* g = SECOND ? ARG(g_ffn) : ARG(g_mix); const float* xp_ = ARG(x_prompt); const float* xs_ = ARG(x_sample);
    const WaveItems wi(T_ALL / 4, gw, NGW);
    for (int k_ = 0; k_ < wi.nk; ++k_) { const int rb = wi.item(k_) * 4;
        f32x4 v[4][4]; float ss[4];
#pragma unroll
        for (int i = 0; i < 4; ++i) { const int r = rb + i;
            const float* src = SECOND ? P.out + (size_t)r * DM : (r < T_P ? xp_ + (size_t)r * DM : xs_ + (size_t)(r - T_P) * DM); ss[i] = 0.f;
#pragma unroll
            for (int j = 0; j < 4; ++j) { v[i][j] = __builtin_nontemporal_load((const f32x4*)(src + 4 * lane + 256 * j)); ss[i] += (v[i][j][0] * v[i][j][0] + v[i][j][1] * v[i][j][1]) + (v[i][j][2] * v[i][j][2] + v[i][j][3] * v[i][j][3]); } }
#pragma unroll
        for (int o = 1; o < 64; o <<= 1) {
#pragma unroll
            for (int i = 0; i < 4; ++i) ss[i] += __shfl_xor(ss[i], o); }
#pragma unroll
        for (int i = 0; i < 4; ++i) { const int r = rb + i; const float rstd = rsqrtf(ss[i] * (1.0f / DM) + EPS);
            const float* mr = mod + (size_t)modrow(r) * MODW; const float* sh = mr + (SECOND ? 3072 : 0); const float* sc = mr + (SECOND ? 4096 : 1024);
            bf16_t* orow = dst + (size_t)r * DM;
#pragma unroll
            for (int j = 0; j < 4; ++j) { const int c0 = 4 * lane + 256 * j; const f32x4 gg = *(const f32x4*)(g + c0);
                f32x4 s1 = *(const f32x4*)(sc + c0), s0 = *(const f32x4*)(sh + c0);
                if (!SECOND) { s1 += *(const f32x4*)(sc + MODP_STRIDE + c0) + *(const f32x4*)(bada + 1024 + c0); s0 += *(const f32x4*)(sh + MODP_STRIDE + c0) + *(const f32x4*)(bada + c0); }
                const f32x4 y = v[i][j] * rstd * gg * (1.0f + s1) + s0;
                u32x2 o; o.x = cvt_pk_bf16(y[0], y[1]); o.y = cvt_pk_bf16(y[2], y[3]); *(u32x2*)(orow + c0) = o; } }
    }
}
__device__ __forceinline__ void ln512(f32x4& a0, f32x4& a1, const f32x4 g0, const f32x4 g1, const f32x4 b0, const f32x4 b1) {
    const float s = (a0[0] + a0[1]) + (a0[2] + a0[3]) + (a1[0] + a1[1]) + (a1[2] + a1[3]);
    const float mean = wave_sum(s) * (1.0f / 512.0f);
    a0 = a0 - mean; a1 = a1 - mean;
    const float q = (a0[0] * a0[0] + a0[1] * a0[1]) + (a0[2] * a0[2] + a0[3] * a0[3]) + (a1[0] * a1[0] + a1[1] * a1[1]) + (a1[2] * a1[2] + a1[3] * a1[3]);
    const float rstd = rsqrtf(wave_sum(q) * (1.0f / 512.0f) + EPS);
    a0 = a0 * rstd * g0 + b0; a1 = a1 * rstd * g1 + b1;
}
__device__ __forceinline__ void conv_tile(const Params& P, PG8_LAS unsigned char* lds, int item, int half, int tid, int lane, int wave) {
    const int b = item >> 4, ck = item & 15, t0 = ck * 128 + 64 * half; const size_t rbase = (size_t)b * 2048;
    const float* a_buf = (const float*)(P.ws + WS_R3); bf16_t* acat = (bf16_t*)(P.ws + WS_R1);
    LAS f32x4* wl = (LAS f32x4*)lds;
    for (int i = tid; i < 31 * 128; i += 512) wl[i] = ((const f32x4*)ARG(w_dw))[i];
    __syncthreads();
    const int c0 = 8 * lane;
    const float* bdp = ARG(b_dw); const float* gcp = ARG(g_cn); const float* bcp = ARG(b_cn);
    for (int g = wave; g < 16; g += 8) {
        const int p0 = t0 + 4 * g;
        f32x4 acc[4][2]; f32x4 wv[4][2];
#pragma unroll
        for (int p = 0; p < 4; ++p) { acc[p][0] = (f32x4){0.f, 0.f, 0.f, 0.f}; acc[p][1] = acc[p][0]; wv[p][0] = acc[p][0]; wv[p][1] = acc[p][0]; }
#pragma unroll 1
        for (int c = 0; c < 5; ++c) {
            f32x4 ar[8][2];
#pragma unroll
            for (int i = 0; i < 8; ++i) { const int rr = 8 * c + i, tpos = p0 - 30 + rr; ar[i][0] = (f32x4){0.f, 0.f, 0.f, 0.f}; ar[i][1] = ar[i][0];
                if (tpos >= 0 && rr < 34) { const float* ap = a_buf + (rbase + tpos) * 512 + c0; ar[i][0] = *(const f32x4*)ap; ar[i][1] = *(const f32x4*)(ap + 4); } }
#pragma unroll
            for (int i = 0; i < 8; ++i) {
                const int rr = 8 * c + i;
                f32x4 w0 = (f32x4){0.f, 0.f, 0.f, 0.f}, w1 = w0;
                if (rr <= 30) { w0 = wl[rr * 128 + 2 * lane]; w1 = wl[rr * 128 + 2 * lane + 1]; }
                wv[i & 3][0] = w0; wv[i & 3][1] = w1;
#pragma unroll
                for (int p = 0; p < 4; ++p) { acc[p][0] += wv[(i - p) & 3][0] * ar[i][0]; acc[p][1] += wv[(i - p) & 3][1] * ar[i][1]; }
            }
        }
#pragma unroll
        for (int p = 0; p < 4; ++p) { f32x4 y0 = acc[p][0] + *(const f32x4*)(bdp + c0), y1 = acc[p][1] + *(const f32x4*)(bdp + c0 + 4);
            ln512(y0, y1, *(const f32x4*)(gcp + c0), *(const f32x4*)(gcp + c0 + 4), *(const f32x4*)(bcp + c0), *(const f32x4*)(bcp + c0 + 4));
#pragma unroll
            for (int e = 0; e < 4; ++e) { y0[e] = y0[e] * sigm(y0[e]); y1[e] = y1[e] * sigm(y1[e]); }
            *(u32x4*)(acat + (rbase + p0 + p) * 1024 + c0) = pack8(y0, y1); }
    }
    if (ck == 15 && half == 1) {
        const f32x4* src = (const f32x4*)(a_buf + (rbase + 2018) * 512); f32x4* dst = (f32x4*)(P.out + OUT_CSP + (size_t)b * 30 * 512);
        for (int i = tid; i < 30 * 128; i += 512) dst[i] = src[i];
    }
    __syncthreads();
}
__device__ __forceinline__ void gmlp_tile(const Params& P, PG8_LAS unsigned char* lds, int item, int hh, int lane, int wave) {
    constexpr int VS = 136;
    const int b = item >> 4, ck = item & 15; const size_t r0 = (size_t)b * 2048 + ck * 128;
    const float* v_buf = (const float*)(P.ws + WS_R5); const bf16_t* u_buf = (const bf16_t*)(P.ws + WS_R4); bf16_t* acat = (bf16_t*)(P.ws + WS_R1);
    LAS bf16_t* VT = (LAS bf16_t*)lds;
    float gv[8], bv[8]; const float* gvp = ARG(g_v); const float* bvp = ARG(b_v); const float* bsp = ARG(b_s);
#pragma unroll
    for (int j = 0; j < 8; ++j) { gv[j] = gvp[lane + 64 * j]; bv[j] = bvp[lane + 64 * j]; }
    for (int jr = wave * 16; jr < wave * 16 + 16; jr += 8) {
        float v[8][8]; float s[8], q[8];
#pragma unroll
        for (int i = 0; i < 8; ++i) { const float* vr = v_buf + (r0 + jr + i) * 512; s[i] = 0.f;
#pragma unroll
            for (int j = 0; j < 8; ++j) { v[i][j] = vr[lane + 64 * j]; s[i] += v[i][j]; } }
#pragma unroll
        for (int o = 1; o < 64; o <<= 1) {
#pragma unroll
            for (int i = 0; i < 8; ++i) s[i] += __shfl_xor(s[i], o); }
#pragma unroll
        for (int i = 0; i < 8; ++i) { const float mean = s[i] * (1.0f / 512.0f); q[i] = 0.f;
#pragma unroll
            for (int j = 0; j < 8; ++j) { v[i][j] -= mean; q[i] += v[i][j] * v[i][j]; } }
#pragma unroll
        for (int o = 1; o < 64; o <<= 1) {
#pragma unroll
            for (int i = 0; i < 8; ++i) q[i] += __shfl_xor(q[i], o); }
#pragma unroll
        for (int i = 0; i < 8; ++i) { const float rstd = rsqrtf(q[i] * (1.0f / 512.0f) + EPS);
#pragma unroll
            for (int j = 0; j < 8; ++j) { if ((j >> 2) == hh) { const float y = v[i][j] * rstd * gv[j] + bv[j]; VT[(lane + 64 * (j & 3)) * VS + jr + i] = (bf16_t)(cvt_pk_bf16(y, 0.f) & 0xffffu); } } }
    }
    __syncthreads();
    const int hl = wave & 3, h = 4 * hh + hl, fr = lane & 15, fq = lane >> 4;
    const float* wsh = ARG(w_s) + (size_t)h * 128 * 128;
#pragma unroll 1
    for (int ii = 0; ii < 2; ++ii) { const int ibp = (wave >> 2) ? 1 + ii : 3 * ii;
        f32x4 acc[2][4];
#pragma unroll
        for (int d = 0; d < 4; ++d) { acc[0][d] = (f32x4){0.f, 0.f, 0.f, 0.f}; acc[1][d] = acc[0][d]; }
        const int i0 = 32 * ibp + fr, i1 = i0 + 16;
        u32x2 uu[2][4];
#pragma unroll
        for (int d = 0; d < 4; ++d) { const int col = h * 64 + 16 * d + 4 * fq; uu[0][d] = *(const u32x2*)(u_buf + (r0 + i0) * 512 + col); uu[1][d] = *(const u32x2*)(u_buf + (r0 + i1) * 512 + col); }
        const float bias0 = bsp[h * 128 + i0], bias1 = bsp[h * 128 + i1];
        for (int ks = 0; ks <= ibp; ++ks) {
            const int j0 = 32 * ks + 8 * fq;
            f32x4 w0 = *(const f32x4*)(wsh + i0 * 128 + j0), w1 = *(const f32x4*)(wsh + i0 * 128 + j0 + 4), x0 = *(const f32x4*)(wsh + i1 * 128 + j0), x1 = *(const f32x4*)(wsh + i1 * 128 + j0 + 4);
#pragma unroll
            for (int e = 0; e < 4; ++e) { if (j0 + e > i0) w0[e] = 0.f; if (j0 + 4 + e > i0) w1[e] = 0.f; if (j0 + e > i1) x0[e] = 0.f; if (j0 + 4 + e > i1) x1[e] = 0.f; }
            const u32x4 wp = pack8(w0, w1), xp = pack8(x0, x1); bf16x8 af0, af1; __builtin_memcpy(&af0, &wp, 16); __builtin_memcpy(&af1, &xp, 16);
#pragma unroll
            for (int d = 0; d < 4; ++d) { const bf16x8 bfr = *(const LAS bf16x8*)(VT + (hl * 64 + 16 * d + fr) * VS + j0);
                acc[0][d] = __builtin_amdgcn_mfma_f32_16x16x32_bf16(bfr, af0, acc[0][d], 0, 0, 0); acc[1][d] = __builtin_amdgcn_mfma_f32_16x16x32_bf16(bfr, af1, acc[1][d], 0, 0, 0); }
        }
#pragma unroll
        for (int z = 0; z < 2; ++z) { const int i = z ? i1 : i0; const float bias = z ? bias1 : bias0;
#pragma unroll
            for (int d = 0; d < 4; ++d) { const int col = h * 64 + 16 * d + 4 * fq; const u32x2 u2 = uu[z][d];
                const float o0 = (acc[z][d][0] + bias) * bf_lo(u2.x), o1 = (acc[z][d][1] + bias) * bf_hi(u2.x), o2 = (acc[z][d][2] + bias) * bf_lo(u2.y), o3 = (acc[z][d][3] + bias) * bf_hi(u2.y);
                u32x2 o; o.x = cvt_pk_bf16(o0, o1); o.y = cvt_pk_bf16(o2, o3); *(u32x2*)(acat + (r0 + i) * 1024 + 512 + col) = o; } }
    }
    __syncthreads();
}
__device__ __forceinline__ void sample_conv_block(const Params& P, PG8_LAS unsigned char* lds, int i, int lane, int wave) {
    const int c0 = 8 * lane; const size_t r = (size_t)T_P + i;
    const float* a_buf = (const float*)(P.ws + WS_R3); const float* scp = ARG(state_conv); const float* wdp = ARG(w_dw);
    float* css = P.out + OUT_CSS + (size_t)i * 30 * 512;
    f32x4 y0 = (f32x4){0.f, 0.f, 0.f, 0.f}, y1 = y0;
#pragma unroll
    for (int q = 0; q < 4; ++q) { const int k = wave + 8 * q;
        if (k < 30) { const float* sp = scp + ((size_t)i * 30 + k) * 512 + c0; const f32x4 s0 = *(const f32x4*)sp, s1 = *(const f32x4*)(sp + 4);
            y0 += *(const f32x4*)(wdp + k * 512 + c0) * s0; y1 += *(const f32x4*)(wdp + k * 512 + c0 + 4) * s1;
            if (k >= 1) { *(f32x4*)(css + (k - 1) * 512 + c0) = s0; *(f32x4*)(css + (k - 1) * 512 + c0 + 4) = s1; } } }
    if (wave == 6) { const f32x4 a0 = *(const f32x4*)(a_buf + r * 512 + c0), a1 = *(const f32x4*)(a_buf + r * 512 + c0 + 4);
        y0 += *(const f32x4*)(wdp + 30 * 512 + c0) * a0; y1 += *(const f32x4*)(wdp + 30 * 512 + c0 + 4) * a1;
        *(f32x4*)(css + 29 * 512 + c0) = a0; *(f32x4*)(css + 29 * 512 + c0 + 4) = a1; }
    LAS f32x4* red = (LAS f32x4*)lds;
    red[wave * 128 + 2 * lane] = y0; red[wave * 128 + 2 * lane + 1] = y1;
    __syncthreads();
    if (wave == 0) { const float* bdp = ARG(b_dw); const float* gcp = ARG(g_cn); const float* bcp = ARG(b_cn);
        f32x4 z0 = *(const f32x4*)(bdp + c0), z1 = *(const f32x4*)(bdp + c0 + 4);
#pragma unroll
        for (int w = 0; w < 8; ++w) { z0 += red[w * 128 + 2 * lane]; z1 += red[w * 128 + 2 * lane + 1]; }
        ln512(z0, z1, *(const f32x4*)(gcp + c0), *(const f32x4*)(gcp + c0 + 4), *(const f32x4*)(bcp + c0), *(const f32x4*)(bcp + c0 + 4));
#pragma unroll
        for (int e = 0; e < 4; ++e) { z0[e] = z0[e] * sigm(z0[e]); z1[e] = z1[e] * sigm(z1[e]); }
        *(u32x4*)((bf16_t*)(P.ws + WS_R1) + r * 1024 + c0) = pack8(z0, z1); }
    __syncthreads();
}
__device__ __forceinline__ void sample_item(const Params& P, int s, int lane) {
    const int i = s >> 1, c0 = 8 * lane; const size_t r = (size_t)T_P + i;
    bf16_t* acat = (bf16_t*)(P.ws + WS_R1);
    if ((s & 1) == 0) {
        const float* a_buf = (const float*)(P.ws + WS_R3);
        const float* bdp = ARG(b_dw); const float* scp = ARG(state_conv); const float* wdp = ARG(w_dw); const float* gcp = ARG(g_cn); const float* bcp = ARG(b_cn);
        f32x4 y0 = *(const f32x4*)(bdp + c0), y1 = *(const f32x4*)(bdp + c0 + 4);
        float* css = P.out + OUT_CSS + (size_t)i * 30 * 512;
        #pragma unroll 6
        for (int k = 0; k < 30; ++k) { const float* sp = scp + ((size_t)i * 30 + k) * 512 + c0; const f32x4 s0 = *(const f32x4*)sp, s1 = *(const f32x4*)(sp + 4);
            y0 += *(const f32x4*)(wdp + k * 512 + c0) * s0; y1 += *(const f32x4*)(wdp + k * 512 + c0 + 4) * s1;
            if (k >= 1) { *(f32x4*)(css + (k - 1) * 512 + c0) = s0; *(f32x4*)(css + (k - 1) * 512 + c0 + 4) = s1; } }
        const f32x4 a0 = *(const f32x4*)(a_buf + r * 512 + c0), a1 = *(const f32x4*)(a_buf + r * 512 + c0 + 4);
        y0 += *(const f32x4*)(wdp + 30 * 512 + c0) * a0; y1 += *(const f32x4*)(wdp + 30 * 512 + c0 + 4) * a1;
        *(f32x4*)(css + 29 * 512 + c0) = a0; *(f32x4*)(css + 29 * 512 + c0 + 4) = a1;
        ln512(y0, y1, *(const f32x4*)(gcp + c0), *(const f32x4*)(gcp + c0 + 4), *(const f32x4*)(bcp + c0), *(const f32x4*)(bcp + c0 + 4));
#pragma unroll
        for (int e = 0; e < 4; ++e) { y0[e] = y0[e] * sigm(y0[e]); y1[e] = y1[e] * sigm(y1[e]); }
        *(u32x4*)(acat + r * 1024 + c0) = pack8(y0, y1);
    } else {
        const float* v_buf = (const float*)(P.ws + WS_R5); const bf16_t* u_buf = (const bf16_t*)(P.ws + WS_R4);
        f32x4 v0 = *(const f32x4*)(v_buf + r * 512 + c0), v1 = *(const f32x4*)(v_buf + r * 512 + c0 + 4);
        const float* gvp = ARG(g_v); const float* bvp = ARG(b_v);
        ln512(v0, v1, *(const f32x4*)(gvp + c0), *(const f32x4*)(gvp + c0 + 4), *(const f32x4*)(bvp + c0), *(const f32x4*)(bvp + c0 + 4));
        float* gvo = P.out + OUT_GV + (size_t)i * 512 + c0; *(f32x4*)gvo = v0; *(f32x4*)(gvo + 4) = v1;
        const int h = lane >> 3; const float w00 = ARG(w_s)[(size_t)h * 128 * 128], b0 = ARG(b_s)[h * 128];
        const u32x4 uu = *(const u32x4*)(u_buf + r * 512 + c0);
        f32x4 o0, o1;
        o0[0] = (w00 * v0[0] + b0) * bf_lo(uu.x); o0[1] = (w00 * v0[1] + b0) * bf_hi(uu.x); o0[2] = (w00 * v0[2] + b0) * bf_lo(uu.y); o0[3] = (w00 * v0[3] + b0) * bf_hi(uu.y);
        o1[0] = (w00 * v1[0] + b0) * bf_lo(uu.z); o1[1] = (w00 * v1[1] + b0) * bf_hi(uu.z); o1[2] = (w00 * v1[2] + b0) * bf_lo(uu.w); o1[3] = (w00 * v1[3] + b0) * bf_hi(uu.w);
        *(u32x4*)(acat + r * 1024 + 512 + c0) = pack8(o0, o1);
    }
}
__device__ __forceinline__ float unordkey(unsigned k) { return __uint_as_float((k & 0x80000000u) ? (k ^ 0x80000000u) : ~k); }
__device__ __forceinline__ unsigned ordkey(float f) { const unsigned u = __float_as_uint(f); return u ^ ((unsigned)((int)u >> 31) | 0x80000000u); }
#define TK_INSERT(arr, x) do { _Pragma("unroll") for (int _i = 0; _i < 16; ++_i) { const unsigned _h = arr[_i] > x ? arr[_i] : x; x = arr[_i] > x ? x : arr[_i]; arr[_i] = _h; } } while (0)
__device__ __forceinline__ void topk_phase(const Params& P, PG8_LAS unsigned char* lds, int lane, int wave, int gw, int NGW) {
    const float* scores = (const float*)(P.ws + WS_R3);
    unsigned short* eid = (unsigned short*)(P.ws + WS_EID); float* gate = (float*)(P.ws + WS_GATE);
    LAS float* lsc = (LAS float*)(lds + wave * 8704); LAS int* lix = (LAS int*)(lds + wave * 8704 + 4352);
    const int NIT_ = T_ALL / 4, extra_ = NIT_ - 2 * NGW; const bool skew_ = extra_ > 0 && extra_ * 2 <= NGW; const int stride_ = skew_ ? NGW / extra_ : 1;
    const int nk_ = skew_ ? (2 + ((gw % stride_ == 0 && gw / stride_ < extra_) ? 1 : 0)) : (gw < NIT_ ? (NIT_ - gw + NGW - 1) / NGW : 0);
    for (int k_ = 0; k_ < nk_; ++k_) { const int it = (skew_ && k_ == 2) ? 2 * NGW + gw / stride_ : gw + k_ * NGW;
        const int uu_ = it < 4096 ? (it >> 3) : 512 + ((it - 4096) >> 2), tg_ = it < 4096 ? (it & 7) : ((it - 4096) & 3), hh_ = uu_ & 7;
        const int tok0_ = (it < 4096 ? (uu_ >> 3) * 256 : T_P) + tg_ * 32;
        {
            const float* sb = scores + (size_t)uu_ * 65536 + (lane >> 5) * 1024 + (tg_ * 32 + (lane & 31)) * 4;
            unsigned s[16]; float vn[16];
#define TK_CE(a, b) do { const unsigned _h = (a) > (b) ? (a) : (b), _l = (a) > (b) ? (b) : (a); (a) = _h; (b) = _l; } while (0)
#pragma unroll
            for (int e = 0; e < 4; ++e) { const f32x4 v4 = __builtin_nontemporal_load((const f32x4*)(sb + e * 2048)); vn[4 * e] = v4[0]; vn[4 * e + 1] = v4[1]; vn[4 * e + 2] = v4[2]; vn[4 * e + 3] = v4[3]; }
#pragma unroll 1
            for (int b = 0; b < 8; ++b) { unsigned k[16];
#pragma unroll
                for (int e = 0; e < 16; ++e) k[e] = (ordkey(vn[e]) & ~127u) | (unsigned)(127 - (16 * b + e));
                if (b < 7) {
#pragma unroll
                    for (int e = 0; e < 4; ++e) { const f32x4 v4 = __builtin_nontemporal_load((const f32x4*)(sb + (4 * (b + 1) + e) * 2048)); vn[4 * e] = v4[0]; vn[4 * e + 1] = v4[1]; vn[4 * e + 2] = v4[2]; vn[4 * e + 3] = v4[3]; } }
#pragma unroll
                for (int kk = 2; kk <= 16; kk <<= 1)
#pragma unroll
                    for (int jj = kk >> 1; jj > 0; jj >>= 1)
#pragma unroll
                        for (int i2 = 0; i2 < 16; ++i2) { const int l = i2 ^ jj; if (l > i2) { if ((i2 & kk) == 0) TK_CE(k[i2], k[l]); else TK_CE(k[l], k[i2]); } }
                if (b == 0) {
#pragma unroll
                    for (int e = 0; e < 16; ++e) s[e] = k[e]; }
                else {
#pragma unroll
                    for (int e = 0; e < 16; ++e) s[e] = s[e] > k[15 - e] ? s[e] : k[15 - e];
#pragma unroll
                    for (int jj = 8; jj > 0; jj >>= 1)
#pragma unroll
                        for (int i2 = 0; i2 < 16; ++i2) { const int l = i2 ^ jj; if (l > i2) TK_CE(s[i2], s[l]); } }
            }
#undef TK_CE
#pragma unroll
            for (int a = 0; a < 16; ++a) { const int idx = 127 - (int)(s[a] & 127u); lix[lane * 17 + a] = idx; lsc[lane * 17 + a] = unordkey((s[a] & ~127u) | 64u); }
        }
        LDS_WAIT();
        {
            const int tk = lane & 31, hs = lane >> 5, tt = tok0_ + tk, h = hh_, base1 = tk * 17, base2 = (32 + tk) * 17;
            unsigned top[16];
#pragma unroll
            for (int a = 0; a < 16; ++a) top[a] = 0u;
            { const int ab = hs ? 1 : 0, a = ab >> 4, b2 = ab & 15; unsigned x = (ordkey(lsc[base1 + a] + lsc[base2 + b2]) & ~255u) | (unsigned)(255 - ab); TK_INSERT(top, x); }
            { const int ab = hs ? 3 : 2, a = ab >> 4, b2 = ab & 15; unsigned x = (ordkey(lsc[base1 + a] + lsc[base2 + b2]) & ~255u) | (unsigned)(255 - ab); TK_INSERT(top, x); }
            { const int ab = hs ? 5 : 4, a = ab >> 4, b2 = ab & 15; unsigned x = (ordkey(lsc[base1 + a] + lsc[base2 + b2]) & ~255u) | (unsigned)(255 - ab); TK_INSERT(top, x); }
            { const int ab = hs ? 7 : 6, a = ab >> 4, b2 = ab & 15; unsigned x = (ordkey(lsc[base1 + a] + lsc[base2 + b2]) & ~255u) | (unsigned)(255 - ab); TK_INSERT(top, x); }
            { const int ab = hs ? 9 : 8, a = ab >> 4, b2 = ab & 15; unsigned x = (ordkey(lsc[base1 + a] + lsc[base2 + b2]) & ~255u) | (unsigned)(255 - ab); TK_INSERT(top, x); }
            { const int ab = hs ? 11 : 10, a = ab >> 4, b2 = ab & 15; unsigned x = (ordkey(lsc[base1 + a] + lsc[base2 + b2]) & ~255u) | (unsigned)(255 - ab); TK_INSERT(top, x); }
            { const int ab = hs ? 13 : 12, a = ab >> 4, b2 = ab & 15; unsigned x = (ordkey(lsc[base1 + a] + lsc[base2 + b2]) & ~255u) | (unsigned)(255 - ab); TK_INSERT(top, x); }
            { const int ab = hs ? 15 : 14, a = ab >> 4, b2 = ab & 15; unsigned x = (ordkey(lsc[base1 + a] + lsc[base2 + b2]) & ~255u) | (unsigned)(255 - ab); TK_INSERT(top, x); }
            { const int ab = hs ? 17 : 16, a = ab >> 4, b2 = ab & 15; unsigned x = (ordkey(lsc[base1 + a] + lsc[base2 + b2]) & ~255u) | (unsigned)(255 - ab); TK_INSERT(top, x); }
            { const int ab = hs ? 19 : 18, a = ab >> 4, b2 = ab & 15; unsigned x = (ordkey(lsc[base1 + a] + lsc[base2 + b2]) & ~255u) | (unsigned)(255 - ab); TK_INSERT(top, x); }
            { const int ab = hs ? 21 : 20, a = ab >> 4, b2 = ab & 15; unsigned x = (ordkey(lsc[base1 + a] + lsc[base2 + b2]) & ~255u) | (unsigned)(255 - ab); TK_INSERT(top, x); }
            { const int ab = hs ? 23 : 22, a = ab >> 4, b2 = ab & 15; unsigned x = (ordkey(lsc[base1 + a] + lsc[base2 + b2]) & ~255u) | (unsigned)(255 - ab); TK_INSERT(top, x); }
            { const int ab = hs ? 33 : 32, a = ab >> 4, b2 = ab & 15; unsigned x = (ordkey(lsc[base1 + a] + lsc[base2 + b2]) & ~255u) | (unsigned)(255 - ab); TK_INSERT(top, x); }
            { const int ab = hs ? 35 : 34, a = ab >> 4, b2 = ab & 15; unsigned x = (ordkey(lsc[base1 + a] + lsc[base2 + b2]) & ~255u) | (unsigned)(255 - ab); TK_INSERT(top, x); }
            { const int ab = hs ? 48 : 36, a = ab >> 4, b2 = ab & 15; unsigned x = (ordkey(lsc[base1 + a] + lsc[base2 + b2]) & ~255u) | (unsigned)(255 - ab); TK_INSERT(top, x); }
            { const int ab = hs ? 50 : 49, a = ab >> 4, b2 = ab & 15; unsigned x = (ordkey(lsc[base1 + a] + lsc[base2 + b2]) & ~255u) | (unsigned)(255 - ab); TK_INSERT(top, x); }
            { const int ab = hs ? 64 : 51, a = ab >> 4, b2 = ab & 15; unsigned x = (ordkey(lsc[base1 + a] + lsc[base2 + b2]) & ~255u) | (unsigned)(255 - ab); TK_INSERT(top, x); }
            { const int ab = hs ? 66 : 65, a = ab >> 4, b2 = ab & 15; unsigned x = (ordkey(lsc[base1 + a] + lsc[base2 + b2]) & ~255u) | (unsigned)(255 - ab); TK_INSERT(top, x); }
            { const int ab = hs ? 81 : 80, a = ab >> 4, b2 = ab & 15; unsigned x = (ordkey(lsc[base1 + a] + lsc[base2 + b2]) & ~255u) | (unsigned)(255 - ab); TK_INSERT(top, x); }
            { const int ab = hs ? 97 : 96, a = ab >> 4, b2 = ab & 15; unsigned x = (ordkey(lsc[base1 + a] + lsc[base2 + b2]) & ~255u) | (unsigned)(255 - ab); TK_INSERT(top, x); }
            { const int ab = hs ? 113 : 112, a = ab >> 4, b2 = ab & 15; unsigned x = (ordkey(lsc[base1 + a] + lsc[base2 + b2]) & ~255u) | (unsigned)(255 - ab); TK_INSERT(top, x); }
            { const int ab = hs ? 144 : 128, a = ab >> 4, b2 = ab & 15; unsigned x = (ordkey(lsc[base1 + a] + lsc[base2 + b2]) & ~255u) | (unsigned)(255 - ab); TK_INSERT(top, x); }
            { const int ab = hs ? 176 : 160, a = ab >> 4, b2 = ab & 15; unsigned x = (ordkey(lsc[base1 + a] + lsc[base2 + b2]) & ~255u) | (unsigned)(255 - ab); TK_INSERT(top, x); }
            { const int ab = hs ? 208 : 192, a = ab >> 4, b2 = ab & 15; unsigned x = (ordkey(lsc[base1 + a] + lsc[base2 + b2]) & ~255u) | (unsigned)(255 - ab); TK_INSERT(top, x); }
            { const int ab = hs ? 240 : 224, a = ab >> 4, b2 = ab & 15; unsigned x = (ordkey(lsc[base1 + a] + lsc[base2 + b2]) & ~255u) | (unsigned)(255 - ab); TK_INSERT(top, x); }
#define TK_CE2(a, b) do { const unsigned _h = (a) > (b) ? (a) : (b), _l = (a) > (b) ? (b) : (a); (a) = _h; (b) = _l; } while (0)
            unsigned m[16];
#pragma unroll
            for (int e2 = 0; e2 < 16; ++e2) { const unsigned o = (unsigned)__shfl_xor((int)top[15 - e2], 32); m[e2] = top[e2] > o ? top[e2] : o; }
#pragma unroll
            for (int jj = 8; jj > 0; jj >>= 1)
#pragma unroll
                for (int i2 = 0; i2 < 16; ++i2) { const int l = i2 ^ jj; if (l > i2) TK_CE2(m[i2], m[l]); }
#undef TK_CE2
            float g[8]; int e[8]; float mx = -3.0e38f; const unsigned hmask = 0u - (unsigned)hs;
#pragma unroll
            for (int j = 0; j < 8; ++j) { const unsigned w = m[j] ^ ((m[j] ^ m[8 + j]) & hmask); const int id = 255 - (int)(w & 255u), a = id >> 4, b2 = id & 15;
                g[j] = lsc[base1 + a] + lsc[base2 + b2]; e[j] = lix[base1 + a] * 128 + lix[base2 + b2]; mx = fmaxf(mx, g[j]); }
            mx = fmaxf(mx, __shfl_xor(mx, 32));
            float sum = 0.f;
#pragma unroll
            for (int j = 0; j < 8; ++j) { g[j] = __expf(g[j] - mx); sum += g[j]; }
            sum += __shfl_xor(sum, 32);
            const float inv = 1.0f / sum;
            unsigned short* ep = eid + (size_t)tt * 128 + h * 16 + 8 * hs; float* gp = gate + (size_t)tt * 128 + h * 16 + 8 * hs;
            *(u32x4*)ep = (u32x4){(unsigned)e[0] | ((unsigned)e[1] << 16), (unsigned)e[2] | ((unsigned)e[3] << 16), (unsigned)e[4] | ((unsigned)e[5] << 16), (unsigned)e[6] | ((unsigned)e[7] << 16)};
            *(f32x4*)gp = (f32x4){g[0] * inv, g[1] * inv, g[2] * inv, g[3] * inv}; *(f32x4*)(gp + 4) = (f32x4){g[4] * inv, g[5] * inv, g[6] * inv, g[7] * inv};
        }
        LDS_WAIT();
    }
}
typedef float f32x2 __attribute__((ext_vector_type(2)));
constexpr size_t WS_U8 = WS_R2, WS_V8 = WS_R2 + 16 * MiB, WS_SU = WS_R2 + 32 * MiB, WS_SV = WS_SU + 65536;
__device__ __forceinline__ void convert_tables(const Params& P, int lane, int gw, int NGW) {
    const float* utab = ARG(u_tab); const float* vtab = ARG(v_tab);
    for (int rb = gw * 4; rb < 32768; rb += NGW * 4) {
        const bool isv = rb >= 16384; const int row0 = rb & 16383;
        const float* src = (isv ? vtab : utab) + (size_t)row0 * DM;
        f32x4 v[4][4]; float am[4];
#pragma unroll
        for (int i = 0; i < 4; ++i) { am[i] = 0.f;
#pragma unroll
            for (int j = 0; j < 4; ++j) { v[i][j] = __builtin_nontemporal_load((const f32x4*)(src + (size_t)i * DM + 4 * lane + 256 * j)); am[i] = fmaxf(am[i], fmaxf(fmaxf(fabsf(v[i][j][0]), fabsf(v[i][j][1])), fmaxf(fabsf(v[i][j][2]), fabsf(v[i][j][3])))); } }
#pragma unroll
        for (int o = 1; o < 64; o <<= 1) {
#pragma unroll
            for (int i = 0; i < 4; ++i) am[i] = fmaxf(am[i], __shfl_xor(am[i], o)); }
#pragma unroll
        for (int i = 0; i < 4; ++i) {
            float sc = 1.0f;
            if (am[i] > 0.f) sc = __uint_as_float(__float_as_uint(448.0f / am[i]) & 0x7F800000u);
            sc = fminf(fmaxf(sc, 1.0e-30f), 1.0e30f);
            u32x4 w;
#pragma unroll
            for (int j = 0; j < 4; ++j) { int p = 0; p = __builtin_amdgcn_cvt_pk_fp8_f32(v[i][j][0] * sc, v[i][j][1] * sc, p, false); p = __builtin_amdgcn_cvt_pk_fp8_f32(v[i][j][2] * sc, v[i][j][3] * sc, p, true); w[j] = (unsigned)p; }
#pragma unroll
            for (int j = 0; j < 4; ++j) *(unsigned*)(P.ws + (isv ? WS_V8 : WS_U8) + (size_t)(2 * j + (lane >> 5)) * (2 * MiB) + (size_t)(row0 + i) * 128 + ((4 * lane) & 127)) = w[j];
            if (lane == 0) ((float*)(P.ws + WS_SU))[2 * (row0 + i) + (isv ? 1 : 0)] = 1.0f / sc;
        }
    }
}
#define DPPF(v, ctrl) __uint_as_float((unsigned)__builtin_amdgcn_update_dpp(0, (int)__float_as_uint(v), (ctrl), 0xf, 0xf, true))
#define PEER_EIDS() const u32x4 ea_ = *(const u32x4*)(eid + (size_t)t * 128 + g * 16), eb_ = *(const u32x4*)(eid + (size_t)t * 128 + g * 16 + 8); \
        const unsigned ew[8] = {ea_.x, ea_.y, ea_.z, ea_.w, eb_.x, eb_.y, eb_.z, eb_.w}; int e0 = 0, e1 = 0; \
        _Pragma("unroll") for (int i = 0; i < 16; ++i) { const int ei = (int)((i & 1) ? (ew[i >> 1] >> 16) : (ew[i >> 1] & 0xffffu)); if (i < 8) e0 = ((i & 7) == p) ? ei : e0; else e1 = ((i & 7) == p) ? ei : e1; }
#define PEER_EI(i) ((size_t)(((i) & 1) ? (ew[(i) >> 1] >> 16) : (ew[(i) >> 1] & 0xffffu)))
__device__ __forceinline__ void peer_a(const Params& P, int lane, int x, int wx, int NW) {
    const unsigned char* u8 = P.ws + WS_U8 + (size_t)x * (2 * MiB); const float* su = (const float*)(P.ws + WS_SU);
    const unsigned short* eid = (const unsigned short*)(P.ws + WS_EID); const bf16_t* n2b = (const bf16_t*)(P.ws + WS_R1); float* part = (float*)(P.ws + WS_PART);
    const int g = lane >> 3, p = lane & 7;
    for (int t = wx; t < T_ALL; t += NW) {
        const u32x4 na = *(const u32x4*)(n2b + (size_t)t * DM + x * 128 + p * 16), nb = *(const u32x4*)(n2b + (size_t)t * DM + x * 128 + p * 16 + 8);
        const unsigned nw[8] = {na.x, na.y, na.z, na.w, nb.x, nb.y, nb.z, nb.w}; f32x2 n2[8];
#pragma unroll
        for (int k = 0; k < 8; ++k) n2[k] = (f32x2){bf_lo(nw[k]), bf_hi(nw[k])};
        PEER_EIDS();
        u32x4 ur[16];
#pragma unroll
        for (int i = 0; i < 16; ++i) ur[i] = *(const u32x4*)(u8 + PEER_EI(i) * 128 + p * 16);
        float k0 = 0.f, k1 = 0.f;
#pragma unroll
        for (int i = 0; i < 16; ++i) { f32x2 dp = (f32x2){0.f, 0.f};
#pragma unroll
            for (int k = 0; k < 4; ++k) { const f32x2 lo = __builtin_amdgcn_cvt_pk_f32_fp8((int)ur[i][k], false), hi = __builtin_amdgcn_cvt_pk_f32_fp8((int)ur[i][k], true); dp += lo * n2[2 * k]; dp += hi * n2[2 * k + 1]; }
            float d = dp.x + dp.y; d += DPPF(d, 0xB1); d += DPPF(d, 0x4E); d += DPPF(d, 0x141);
            if (i & 1) k1 = ((i >> 1) == p) ? d : k1; else k0 = ((i >> 1) == p) ? d : k0; }
        __builtin_nontemporal_store(cvt_pk_bf16(k0, k1), (unsigned*)part + ((size_t)t * 8 + x) * 64 + g * 8 + p);
    }
}
__device__ __forceinline__ void peer_a2(const Params& P, int lane, int gw, int NGW) {
    const float* part = (const float*)(P.ws + WS_PART); const float* gate = (const float*)(P.ws + WS_GATE); const float* sv = (const float*)(P.ws + WS_SV); const float* su = (const float*)(P.ws + WS_SU);
    const unsigned short* eid = (const unsigned short*)(P.ws + WS_EID); float* cfo = (float*)(P.ws + WS_CF);
    const WaveItems wi(T_ALL, gw, NGW);
    for (int k_ = 0; k_ < wi.nk; ++k_) { const int t = wi.item(k_);
        float d0 = 0.f, d1 = 0.f;
#pragma unroll
        for (int xx = 0; xx < 8; ++xx) { const unsigned w = __builtin_nontemporal_load((const unsigned*)part + ((size_t)t * 8 + xx) * 64 + lane); d0 += bf_lo(w); d1 += bf_hi(w); }
        const unsigned ew = ((const unsigned*)eid)[(size_t)t * 64 + lane]; const int ea = (int)(ew & 0xffffu), eb = (int)(ew >> 16); const f32x2 sa = *(const f32x2*)(su + 2 * ea), sb = *(const f32x2*)(su + 2 * eb); const float s0 = sa.y, s1 = sb.y;
        d0 *= sa.x; d1 *= sb.x;
        const f32x2 gg = *(const f32x2*)(gate + (size_t)t * 128 + 2 * lane);
        *(f32x2*)(cfo + (size_t)t * 128 + 2 * lane) = (f32x2){gg.x * 0.5f * d0 * (1.0f + erff(d0 * 0.70710678118654752f)) * s0, gg.y * 0.5f * d1 * (1.0f + erff(d1 * 0.70710678118654752f)) * s1};
    }
}
__device__ __forceinline__ void peer_b(const Params& P, LAS float* cfbuf, int lane, int x, int wx, int NW) {
    const unsigned char* v8 = P.ws + WS_V8 + (size_t)x * (2 * MiB); const float* sv = (const float*)(P.ws + WS_SV);
    const unsigned short* eid = (const unsigned short*)(P.ws + WS_EID); const float* cfi = (const float*)(P.ws + WS_CF);
    const float* mod = (const float*)(P.ws + WS_MOD); float* sumsq = (float*)(P.ws + WS_SUMSQ);
    const int g = lane >> 3, p = lane & 7;
    for (int t = wx; t < T_ALL; t += NW) {
        PEER_EIDS();
        u32x4 vr[16];
#pragma unroll
        for (int i = 0; i < 16; ++i) vr[i] = *(const u32x4*)(v8 + PEER_EI(i) * 128 + p * 16);
        const float cf0 = cfi[(size_t)t * 128 + g * 16 + p], cf1 = cfi[(size_t)t * 128 + g * 16 + 8 + p];
        cfbuf[g * 16 + p] = cf0; cfbuf[g * 16 + 8 + p] = cf1;
        asm volatile("s_waitcnt lgkmcnt(0)" ::: "memory");
        f32x4 cfr[4];
#pragma unroll
        for (int k = 0; k < 4; ++k) cfr[k] = *(const LAS f32x4*)(cfbuf + g * 16 + 4 * k);
        asm volatile("s_waitcnt lgkmcnt(0)" ::: "memory");
        f32x2 acc[8];
#pragma unroll
        for (int k = 0; k < 8; ++k) acc[k] = (f32x2){0.f, 0.f};
#pragma unroll
        for (int i = 0; i < 16; ++i) { const float cf = cfr[i >> 2][i & 3]; const f32x2 cfv = (f32x2){cf, cf};
#pragma unroll
            for (int k = 0; k < 4; ++k) { const f32x2 lo = __builtin_amdgcn_cvt_pk_f32_fp8((int)vr[i][k], false), hi = __builtin_amdgcn_cvt_pk_f32_fp8((int)vr[i][k], true); acc[2 * k] += cfv * lo; acc[2 * k + 1] += cfv * hi; } }
        f32x2 r4[4], r2[2], r1;
#pragma unroll
        for (int k = 0; k < 4; ++k) { const f32x2 keep = (lane & 8) ? acc[k + 4] : acc[k], send = (lane & 8) ? acc[k] : acc[k + 4]; r4[k] = keep + (f32x2){DPPF(send.x, 0x128), DPPF(send.y, 0x128)}; }
#pragma unroll
        for (int k = 0; k < 2; ++k) { const f32x2 keep = (lane & 16) ? r4[k + 2] : r4[k], send = (lane & 16) ? r4[k] : r4[k + 2]; r2[k] = keep + (f32x2){__shfl_xor(send.x, 16), __shfl_xor(send.y, 16)}; }
        { const f32x2 keep = (lane & 32) ? r2[1] : r2[0], send = (lane & 32) ? r2[0] : r2[1]; r1 = keep + (f32x2){__shfl_xor(send.x, 32), __shfl_xor(send.y, 32)}; }
        const int col = x * 128 + p * 16 + 2 * (((lane >> 3) & 1) * 4 + ((lane >> 4) & 1) * 2 + ((lane >> 5) & 1));
        __builtin_nontemporal_store(cvt_pk_bf16(r1.x, r1.y), (unsigned*)((bf16_t*)(P.ws + WS_R1) + (size_t)t * DM + col));
    }
}
__device__ __forceinline__ void peer_c(const Params& P, int lane, int gw, int NGW) {
    const float* mod = (const float*)(P.ws + WS_MOD); const bf16_t* po = (const bf16_t*)(P.ws + WS_R1); const float* gfin = ARG(g_final);
    const WaveItems wi(T_ALL, gw, NGW);
    for (int k_ = 0; k_ < wi.nk; ++k_) { const int t = wi.item(k_);
        float* xr = P.out + (size_t)t * DM; const float* gt = mod + (size_t)modrow(t) * MODW + 5120;
        f32x4 x2[4]; float ss = 0.f;
#pragma unroll
        for (int j = 0; j < 4; ++j) { const int c0 = 4 * lane + 256 * j; const u32x2 d = __builtin_nontemporal_load((const u32x2*)(po + (size_t)t * DM + c0));
            x2[j] = __builtin_nontemporal_load((const f32x4*)(xr + c0)) + *(const f32x4*)(gt + c0) * (f32x4){bf_lo(d.x), bf_hi(d.x), bf_lo(d.y), bf_hi(d.y)};
            ss += (x2[j][0] * x2[j][0] + x2[j][1] * x2[j][1]) + (x2[j][2] * x2[j][2] + x2[j][3] * x2[j][3]); }
        const float rstd = rsqrtf(wave_sum(ss) * (1.0f / DM) + EPS);
#pragma unroll
        for (int j = 0; j < 4; ++j) { const int c0 = 4 * lane + 256 * j; __builtin_nontemporal_store(x2[j] * rstd * *(const f32x4*)(gfin + c0), (f32x4*)(xr + c0)); }
    }
}
template <int NF> __device__ __forceinline__ void wave_mma(const bf16_t* Ap, const bf16_t* const (&Bp)[NF], int K, f32x4 (&acc)[NF]) {
#pragma unroll 8
    for (int k = 0; k < K; k += 32) { const bf16x8 a = *(const bf16x8*)(Ap + k);
#pragma unroll
        for (int f = 0; f < NF; ++f) { const bf16x8 b = *(const bf16x8*)(Bp[f] + k); acc[f] = __builtin_amdgcn_mfma_f32_16x16x32_bf16(b, a, acc[f], 0, 0, 0); } }
}
__device__ __forceinline__ u32x2 pack4(f32x4 v) { u32x2 o; o.x = cvt_pk_bf16(v[0], v[1]); o.y = cvt_pk_bf16(v[2], v[3]); return o; }
__device__ __forceinline__ void sample_z(const Params& P, int lane, int gw, int NGW) {
    const int fr = lane & 15, fq = lane >> 4; unsigned char* ws = P.ws;
    const bf16_t* A = (const bf16_t*)(ws + WS_R1) + (size_t)T_P * 1024; const bf16_t* W = (const bf16_t*)(ws + WS_WINT);
    for (int it = gw; it < 1792; it += NGW) {
        if (it < 256) { const int cf = it >> 3, rf = it & 7, ch0 = 16 * cf; const size_t r = (size_t)T_P + 16 * rf + fr;
            const bf16_t* Ap = A + (size_t)(16 * rf + fr) * 1024 + 8 * fq;
            const bf16_t* const Bp[2] = {W + (size_t)(winmap(ch0) + fr) * 1024 + 8 * fq, W + (size_t)(winmap(512 + ch0) + fr) * 1024 + 8 * fq};
            f32x4 acc[2] = {(f32x4){0.f, 0.f, 0.f, 0.f}, (f32x4){0.f, 0.f, 0.f, 0.f}};
            wave_mma<2>(Ap, Bp, 1024, acc);
            f32x4 o;
#pragma unroll
            for (int e = 0; e < 4; ++e) o[e] = acc[0][e] * sigm(acc[1][e]);
            *(f32x4*)((float*)(ws + WS_R3) + r * 512 + ch0 + 4 * fq) = o;
        } else { const int it2 = it - 256, cf = it2 >> 3, rf = it2 & 7, n0 = 1024 + 16 * cf; const size_t r = (size_t)T_P + 16 * rf + fr;
            const bf16_t* Ap = A + (size_t)(16 * rf + fr) * 1024 + 8 * fq;
            const bf16_t* const Bp[1] = {W + (size_t)(n0 + fr) * 1024 + 8 * fq};
            f32x4 acc[1] = {(f32x4){0.f, 0.f, 0.f, 0.f}};
            wave_mma<1>(Ap, Bp, 1024, acc);
            if (n0 < 1536) *(u32x2*)((bf16_t*)(ws + WS_R4) + r * 512 + (n0 - 1024) + 4 * fq) = pack4(acc[0]);
            else if (n0 < 2048) *(f32x4*)((float*)(ws + WS_R5) + r * 512 + (n0 - 1536) + 4 * fq) = acc[0];
            else { f32x4 sg;
#pragma unroll
                for (int e = 0; e < 4; ++e) sg[e] = sigm(acc[0][e]);
                bf16_t* gdst = (bf16_t*)(ws + WS_R2) + (n0 < 3072 ? (size_t)0 : (size_t)MP * 1024);
                *(u32x2*)(gdst + r * 1024 + ((n0 - 2048) & 1023) + 4 * fq) = pack4(sg); }
        }
    }
}
__device__ __forceinline__ void sample_m(const Params& P, int lane, int gw, int NGW) {
    const int fr = lane & 15, fq = lane >> 4; unsigned char* ws = P.ws;
    const bf16_t* A = (const bf16_t*)(ws + WS_R1) + (size_t)T_P * 1024; const bf16_t* W = (const bf16_t*)(ws + WS_WCGT);
    const bf16_t* ga = (const bf16_t*)(ws + WS_R2); const bf16_t* gb = ga + (size_t)MP * 1024; bf16_t* mb = (bf16_t*)(ws + WS_R3);
    for (int it = gw; it < 512; it += NGW) { const int cf = it >> 3, rf = it & 7, n0 = 16 * cf; const size_t r = (size_t)T_P + 16 * rf + fr;
        const bf16_t* Ap = A + (size_t)(16 * rf + fr) * 1024 + 8 * fq;
        const bf16_t* const Bp[1] = {W + (size_t)(n0 + fr) * 1024 + 8 * fq};
        f32x4 acc[1] = {(f32x4){0.f, 0.f, 0.f, 0.f}};
        wave_mma<1>(Ap, Bp, 512, acc);
        const u32x2 a2 = *(const u32x2*)(ga + r * 1024 + n0 + 4 * fq), b2 = *(const u32x2*)(gb + r * 1024 + n0 + 4 * fq);
        const f32x4 gav = (f32x4){bf_lo(a2.x), bf_hi(a2.x), bf_lo(a2.y), bf_hi(a2.y)}, gbv = (f32x4){bf_lo(b2.x), bf_hi(b2.x), bf_lo(b2.y), bf_hi(b2.y)};
#pragma unroll
        for (int e = 0; e < 4; ++e) acc[0][e] *= gav[e] * __builtin_amdgcn_rcpf(fmaxf(gbv[e], 1e-30f));
        const bf16_t* Ap2 = Ap + 512; const bf16_t* const Bp2[1] = {Bp[0] + 512};
        wave_mma<1>(Ap2, Bp2, 512, acc);
        *(u32x2*)(mb + r * 1024 + n0 + 4 * fq) = pack4(acc[0] * gbv);
    }
}
__device__ __forceinline__ void sample_x1(const Params& P, int lane, int gw, int NGW) {
    const int fr = lane & 15, fq = lane >> 4; unsigned char* ws = P.ws;
    const bf16_t* A = (const bf16_t*)(ws + WS_R3) + (size_t)T_P * 1024; const bf16_t* W = (const bf16_t*)(ws + WS_WOUTT);
    const float* xs = ARG(x_sample); const float* mod = (const float*)(ws + WS_MOD);
    for (int it = gw; it < 512; it += NGW) { const int cf = it >> 3, rf = it & 7, n0 = 16 * cf, i = 16 * rf + fr;
        const bf16_t* Ap = A + (size_t)i * 1024 + 8 * fq;
        const bf16_t* const Bp[1] = {W + (size_t)(n0 + fr) * 1024 + 8 * fq};
        f32x4 acc[1] = {(f32x4){0.f, 0.f, 0.f, 0.f}};
        wave_mma<1>(Ap, Bp, 1024, acc);
        const int c = n0 + 4 * fq;
        *(f32x4*)(P.out + ((size_t)T_P + i) * DM + c) = *(const f32x4*)(xs + (size_t)i * DM + c) + *(const f32x4*)(mod + (size_t)(8 + i) * MODW + 2048 + c) * acc[0];
    }
}
__device__ __forceinline__ void sample_s(const Params& P, int lane, int gw, int NGW) {
    const int fr = lane & 15, fq = lane >> 4; unsigned char* ws = P.ws;
    const bf16_t* A = (const bf16_t*)(ws + WS_R1) + (size_t)T_P * 1024; const bf16_t* W = (const bf16_t*)(ws + WS_WQT); float* sc = (float*)(ws + WS_R3);
    for (int it = gw; it < 1024; it += NGW) { const int cf = it >> 3, rf = it & 7, n0 = 16 * cf, h = n0 >> 8, half = (n0 >> 7) & 1, j0 = (n0 & 127) + 4 * fq;
        const bf16_t* Ap = A + (size_t)(16 * rf + fr) * 1024 + 8 * fq;
        const bf16_t* const Bp[1] = {W + (size_t)(n0 + fr) * 1024 + 8 * fq};
        f32x4 acc[1] = {(f32x4){0.f, 0.f, 0.f, 0.f}};
        wave_mma<1>(Ap, Bp, 1024, acc);
        *(f32x4*)(sc + (size_t)(512 + h) * 65536 + (size_t)(j0 >> 2) * 2048 + half * 1024 + (16 * rf + fr) * 4) = acc[0];
    }
}
#define XB_TMO      128
#define XB_XCNT(j)  (256  + 64 * (j))
#define XB_XSUB(j)  (1280 + 64 * (j))
#define XB_XGEN(j)  (2304 + 64 * (j))
#define XB_TOP      3328
#define XB_TOPGEN   3392
#define XCD_BAR_WORDS 3456
#define XB_SPIN_CAP (1u << 18)

__device__ __forceinline__ unsigned xb_ld(unsigned* p)              { return __hip_atomic_load(p, __ATOMIC_RELAXED, __HIP_MEMORY_SCOPE_AGENT); }
__device__ __forceinline__ unsigned xb_add(unsigned* p, unsigned v) { return __hip_atomic_fetch_add(p, v, __ATOMIC_RELAXED, __HIP_MEMORY_SCOPE_AGENT); }
__device__ __forceinline__ unsigned xb_xcc_id() { return (unsigned)__builtin_amdgcn_s_getreg((3 << 11) | 20) & 0xFu; }
#define XB_SPIN(cond, bar) do { unsigned _sp = 0; while (cond) { __builtin_amdgcn_s_sleep(1); \
    if ((++_sp & 255u) == 0u) { if (xb_ld(&(bar)[XB_TMO])) break; if (_sp > XB_SPIN_CAP) { atomicAdd(&(bar)[XB_TMO], 1u); break; } } } } while (0)

struct XcdBarrier {
    unsigned* bar; unsigned x;
    volatile LAS unsigned* st;
};

__device__ __forceinline__ XcdBarrier xcd_barrier_post(unsigned* bar, volatile LAS unsigned* st) {
    XcdBarrier b; b.bar = bar; b.x = xb_xcc_id(); b.st = st;
    if (threadIdx.x == 0) (void)xb_add(&bar[XB_XCNT(b.x)], 1u);
    return b;
}
__device__ __forceinline__ void xcd_barrier_complete(unsigned* bar, unsigned x, unsigned& nloc, unsigned& nx) {
    const unsigned G = gridDim.x * gridDim.y * gridDim.z;
    unsigned sum, cnt, mine, sp = 0u;
    for (;;) {
        sum = 0u; cnt = 0u; mine = 0u;
#pragma unroll
        for (unsigned j = 0; j < 16; ++j) { const unsigned c = xb_ld(&bar[XB_XCNT(j)]); sum += c; cnt += (c > 0u) ? 1u : 0u; mine = (j == x) ? c : mine; }
        if (sum == G) break;
        __builtin_amdgcn_s_sleep(1);
        if ((++sp & 255u) == 0u) { if (xb_ld(&bar[XB_TMO])) break; if (sp > XB_SPIN_CAP) { atomicAdd(&bar[XB_TMO], 1u); break; } }
    }
    nloc = mine > 0u ? mine : 1u; nx = cnt > 0u ? cnt : 1u;
}

__device__ __forceinline__ void xcd_barrier(const XcdBarrier& b) {
    asm volatile("s_waitcnt vmcnt(0)" ::: "memory");
    __syncthreads();
    if (threadIdx.x == 0) {
        unsigned* bar = b.bar;
        __builtin_amdgcn_s_waitcnt(0);
        unsigned nloc = b.st[0], nx = b.st[1];
        if (nloc == 0u) { xcd_barrier_complete(bar, b.x, nloc, nx); b.st[0] = nloc; b.st[1] = nx; }
        const unsigned old = xb_add(&bar[XB_XSUB(b.x)], 1u);
        const unsigned gen = old / nloc;
        if (old + 1u == (gen + 1u) * nloc) {
            __builtin_amdgcn_fence(__ATOMIC_RELEASE, "agent");
            asm volatile("s_waitcnt vmcnt(0)" ::: "memory");
            const unsigned og = xb_add(&bar[XB_TOP], 1u);
            const unsigned tg = og / nx;
            if (og + 1u == (tg + 1u) * nx) xb_add(&bar[XB_TOPGEN], 1u);
            else XB_SPIN(xb_ld(&bar[XB_TOPGEN]) == tg, bar);
            __builtin_amdgcn_fence(__ATOMIC_ACQUIRE, "agent");
            xb_add(&bar[XB_XGEN(b.x)], 1u);
            asm volatile("s_waitcnt vmcnt(0)" ::: "memory");
        } else {
            XB_SPIN(xb_ld(&bar[XB_XGEN(b.x)]) == gen, bar);
            __builtin_amdgcn_fence(__ATOMIC_ACQUIRE, "agent");
            asm volatile("s_waitcnt vmcnt(0)" ::: "memory");
        }
    }
    __syncthreads();
}


__global__ void __launch_bounds__(512) mega(Params P) {
    extern __shared__ __attribute__((aligned(16))) unsigned char smem[];
    PG8_LAS unsigned char* lds = (PG8_LAS unsigned char*)smem;
    cg::grid_group grid = cg::this_grid();
    const int tid = threadIdx.x, lane = tid & 63, wave = __builtin_amdgcn_readfirstlane(tid >> 6), G = gridDim.x, gw = blockIdx.x * 8 + wave, NGW = G * 8;
    unsigned char* ws = P.ws;
    const int lo = P.ph_lo, hi = P.ph_hi;
    if (lo > hi) grid.sync();
    volatile LAS unsigned* xst = (volatile LAS unsigned*)(lds + LDS_MAIN);
    if (tid == 0) { xst[0] = 0u; xst[1] = 0u; const unsigned xc = xb_xcc_id() & 7u; xst[2] = xc; xst[3] = xb_add((unsigned*)(ws + WS_CNT2) + 64 * xc, 1u); }
    __syncthreads();
    (void)xcd_barrier_post((unsigned*)ws, xst);
#define IN(k) (lo <= (k) && (k) < hi && PHON(k))
#define SEAM(k) do { if (lo <= (k) && (k) + 1 < hi) { XcdBarrier xb_; xb_.bar = (unsigned*)ws; xb_.x = xb_xcc_id(); xb_.st = xst; xcd_barrier(xb_); } } while (0)
    if (IN(0)) for (int rep_ = 0; rep_ < REPS(0); ++rep_) phase0<0>(P, lds, lane, wave, gw, NGW);
    SEAM(0);
    if (IN(1)) for (int rep_ = 0; rep_ < REPS(1); ++rep_) {
        pg8::Gemm g = pg8::mk_gemm((const bf16_t*)(ws + WS_CS), (const bf16_t*)(ws + WS_R3), 256, MODW, 512, 1024); pg8::KSplitOrder S; S.init(MODW, 2, G, (int)blockIdx.x);
        constexpr int NU = 2 * (MODW / 256), NW_ = 32;
        pg8::Gemm gw_ = pg8::mk_gemm((const bf16_t*)(ws + WS_KBLK), (const bf16_t*)(ws + WS_WQN), 2048, 1024, 256, 256);
        gw_.ldb = 2048; gw_.a_tile = 0; gw_.b_tile = (size_t)256 * 2048 * 2; gw_.b_pm = 512;
        const bool split_ = G >= NU + NW_ + 8; const int b_ = (int)blockIdx.x;
        if (!split_ || b_ < NU) { EpiMod E{(float*)(ws + WS_MODP), nullptr}; pg8::gemm_phase<EpiMod, pg8::KSplitOrder>(lds, g, S, E); }
        if (!split_ || (b_ >= NU && b_ < NU + NW_)) { pg8::StaticOrder S2; S2.init(2048, 1024, G, split_ ? b_ - NU : b_); EpiW E2{(bf16_t*)(ws + WS_WQT)}; pg8::gemm_phase<EpiW, pg8::StaticOrder>(lds, gw_, S2, E2); }
        if (!split_ || b_ >= NU + NW_) phase0<1>(P, lds, lane, wave, split_ ? gw - (NU + NW_) * 8 : gw, split_ ? NGW - (NU + NW_) * 8 : NGW);
    }
    SEAM(1);
    if (IN(2)) for (int rep_ = 0; rep_ < REPS(2); ++rep_) {
        {
            const float* mp = (const float*)(ws + WS_MODP); float* mo = (float*)(ws + WS_MOD); const float* bada = ARG(b_ada);
            for (int q = gw * 64 + lane; q < 136 * 1024; q += NGW * 64) { const int r = q >> 10, c = 2048 + 4 * (q & 1023); const size_t o = (size_t)r * MODW + c;
                *(f32x4*)(mo + o) = *(const f32x4*)(mp + o) + *(const f32x4*)(mp + MODP_STRIDE + o) + *(const f32x4*)(bada + c); } }
        norm_rows<false>(P, (bf16_t*)(ws + WS_R1), lane, gw, NGW); }
    SEAM(2);
    if (IN(3)) for (int rep_ = 0; rep_ < REPS(3); ++rep_) {
        sample_z(P, lane, gw, NGW);
        pg8::Gemm g = pg8::mk_gemm((const bf16_t*)(ws + WS_R1), (const bf16_t*)(ws + WS_WINT), T_P, 4096, 1024, 1024); pg8::StaticOrder S; S.init(T_P, 4096, G, (int)blockIdx.x);
        EpiZ E{(float*)(ws + WS_R3), (bf16_t*)(ws + WS_R4), (float*)(ws + WS_R5), (bf16_t*)(ws + WS_R2), (bf16_t*)(ws + WS_R2) + (size_t)MP * 1024};
        pg8::gemm_phase<EpiZ, pg8::StaticOrder>(lds, g, S, E);
    }
    SEAM(3);
    if (IN(4)) for (int rep_ = 0; rep_ < REPS(4); ++rep_) {
        for (int it = blockIdx.x; it < 256; it += G) { conv_tile(P, lds, it >> 1, it & 1, tid, lane, wave); gmlp_tile(P, lds, it >> 1, it & 1, lane, wave); }
        for (int s = (int)blockIdx.x; s < 256; s += G) { if ((s & 1) == 0) sample_conv_block(P, lds, s >> 1, lane, wave); else if (wave == 0) sample_item(P, s, lane); }
    }
    SEAM(4);
    if (IN(5)) for (int rep_ = 0; rep_ < REPS(5); ++rep_) {
        sample_m(P, lane, gw, NGW);
        pg8::Gemm g = pg8::mk_gemm((const bf16_t*)(ws + WS_R1), (const bf16_t*)(ws + WS_WCGT), T_P, 1024, 512, 1024); pg8::SplitOrder S; S.init(T_P, 1024, G, (int)blockIdx.x);
        EpiM E{(const bf16_t*)(ws + WS_R2), (const bf16_t*)(ws + WS_R2) + (size_t)MP * 1024, (bf16_t*)(ws + WS_R3)};
        pg8::gemm_phase<EpiM, pg8::SplitOrder>(lds, g, S, E);
    }
    SEAM(5);
    if (IN(6)) for (int rep_ = 0; rep_ < REPS(6); ++rep_) {
        sample_x1(P, lane, gw, NGW);
        pg8::Gemm g = pg8::mk_gemm((const bf16_t*)(ws + WS_R3), (const bf16_t*)(ws + WS_WOUTT), T_P, 1024, 1024, 1024); pg8::StaticOrder S; S.init(T_P, 1024, G, (int)blockIdx.x);
        EpiX1 E{ARG(x_prompt), ARG(x_sample), (const float*)(ws + WS_MOD), P.out}; pg8::gemm_phase<EpiX1, pg8::StaticOrder>(lds, g, S, E);
    }
    SEAM(6);
    if (IN(7)) for (int rep_ = 0; rep_ < REPS(7); ++rep_) norm_rows<true>(P, (bf16_t*)(ws + WS_R1), lane, gw, NGW);
    SEAM(7);
    if (IN(8)) for (int rep_ = 0; rep_ < REPS(8); ++rep_) {
        if (blockIdx.x & 1) convert_tables(P, lane, gw, NGW);
        sample_s(P, lane, gw, NGW);
        pg8::Gemm g = pg8::mk_gemm((const bf16_t*)(ws + WS_R1), (const bf16_t*)(ws + WS_WQT), T_P, 2048, 1024, 1024); pg8::StaticOrder S; S.init(T_P, 2048, G, (int)blockIdx.x);
        EpiS2 E{(float*)(ws + WS_R3)}; pg8::gemm_phase<EpiS2, pg8::StaticOrder>(lds, g, S, E);
        if (!(blockIdx.x & 1)) convert_tables(P, lane, gw, NGW);
    }
    SEAM(8);
    if (IN(10)) for (int rep_ = 0; rep_ < REPS(10); ++rep_) topk_phase(P, lds, lane, wave, gw, NGW);
    SEAM(10);
    int px = (int)xst[2], prank = (int)xst[3], pn = 1;
    if (IN(11) || IN(13)) { unsigned cn[8]; bool ok = true;
#pragma unroll
        for (int j = 0; j < 8; ++j) { cn[j] = xb_ld((unsigned*)(ws + WS_CNT2) + 64 * j); ok = ok && cn[j] > 0u; }
        if (ok) { pn = (int)cn[0];
#pragma unroll
            for (int j = 1; j < 8; ++j) pn = (px == j) ? (int)cn[j] : pn; }
        else { px = (int)blockIdx.x & 7; prank = (int)blockIdx.x >> 3; pn = (G + 7 - px) / 8; } }
    if (IN(11)) peer_a(P, lane, px, prank * 8 + wave, pn * 8);
    SEAM(11);
    if (IN(12)) peer_a2(P, lane, gw, NGW);
    SEAM(12);
    if (IN(13)) peer_b(P, (LAS float*)(lds + wave * 512), lane, px, prank * 8 + wave, pn * 8);
    SEAM(13);
    if (IN(14)) peer_c(P, lane, gw, NGW);
#undef IN
#undef SEAM
}

extern "C" void kernel_launch(void* const* d_in, const int* in_sizes, int n_in, void* d_out, int out_size, void* d_ws, size_t ws_size, hipStream_t stream) {
    static int grid = 0;
    if (grid == 0) {
        if (n_in != 27 || ws_size < WS_END) { fprintf(stderr, "kernel_launch: need 27 inputs and >= %zu bytes of workspace; got %d, %zu\n", (size_t)WS_END, n_in, ws_size); grid = -1; return; }
        int dev = 0, cus = 0, per_cu = 0;
        (void)hipGetDevice(&dev); (void)hipDeviceGetAttribute(&cus, hipDeviceAttributeMultiprocessorCount, dev);
        if (hipFuncSetAttribute((const void*)mega, hipFuncAttributeMaxDynamicSharedMemorySize, LDS_BYTES) != hipSuccess) { fprintf(stderr, "kernel_launch: hipFuncSetAttribute failed\n"); grid = -1; return; }
        if (hipOccupancyMaxActiveBlocksPerMultiprocessor(&per_cu, (const void*)mega, 512, LDS_BYTES) != hipSuccess || per_cu < 1) { fprintf(stderr, "kernel_launch: occupancy query says %d blocks per CU\n", per_cu); (void)hipGetLastError(); grid = -1; return; }
        grid = cus;
    }
    if (grid < 0) return;
    if (hipMemsetAsync(d_ws, 0, WS_CTL_BYTES, stream) != hipSuccess) { fprintf(stderr, "kernel_launch: memset of the barrier words failed\n"); return; }
    Params p{};
    for (int i = 0; i < 27; ++i) p.in[i] = (const float*)d_in[i];
    p.out = (float*)d_out; p.ws = (unsigned char*)d_ws;
#if defined(MK_MULTI)
    for (int ph = 0; ph < NPH; ++ph) { p.ph_lo = ph; p.ph_hi = ph + 1; void* args[] = {&p};
        hipError_t e = hipLaunchCooperativeKernel((const void*)mega, dim3(grid), dim3(512), args, LDS_BYTES, stream);
        if (e != hipSuccess) fprintf(stderr, "launch failed: %s\n", hipGetErrorString(e)); }
#else
    p.ph_lo = 0; p.ph_hi = NPH; void* args[] = {&p};
    hipError_t e = hipLaunchCooperativeKernel((const void*)mega, dim3(grid), dim3(512), args, LDS_BYTES, stream);
    if (e != hipSuccess) fprintf(stderr, "cooperative launch failed: %s (grid %d)\n", hipGetErrorString(e), grid);
#endif
}
```

```cpp
#include <hip/hip_runtime.h>
#include <hip/hip_cooperative_groups.h>
#include <cstdio>
#include <cstdint>
namespace cg = cooperative_groups;
namespace pg8 {
#define PG8_LAS __attribute__((address_space(3)))
typedef unsigned short bf16_t;
typedef short bf16x8 __attribute__((ext_vector_type(8)));
typedef float f32x4 __attribute__((ext_vector_type(4)));
typedef unsigned u32x4 __attribute__((ext_vector_type(4)));
constexpr int BM = 256, BK = 64, HALF = 128, HTB = HALF * BK * 2  , STAGE_BYTES = 8 * HTB, NXCD = 8, WGM = 8;

__host__ __device__ __forceinline__ int lds_byte(int r, int c) { const int st = (r >> 4) * 2 + (c >> 5), rr = r & 15, cc = c & 31, ob = rr * 64 + cc * 2; return st * 1024 + (ob ^ (((ob >> 9) & 1) << 5)); }
__host__ __device__ __forceinline__ void stage_rc(int b, int& R, int& C) { const int st = b / 1024, sb = b % 1024, swz = sb ^ (((sb >> 9) & 1) << 5); R = (st >> 1) * 16 + swz / 64; C = (st & 1) * 32 + (swz % 64) / 2; }
__host__ __device__ __forceinline__ int perm32(int rho) { const int n = rho >> 4, i = rho & 15; return 8 * (i >> 2) + 4 * n + (i & 3); }

struct Unit { int pm, pn, kh; };
struct Gemm { const bf16_t* A; const bf16_t* Bt; int M, N, K, lda, ldb; size_t a_tile, b_tile, b_pm; };
__host__ __device__ __forceinline__ Gemm mk_gemm(const bf16_t* A, const bf16_t* Bt, int M, int N, int K, int ld) { Gemm g; g.A = A; g.Bt = Bt; g.M = M; g.N = N; g.K = K; g.lda = ld; g.ldb = ld; g.a_tile = (size_t)256 * ld * 2; g.b_tile = (size_t)256 * ld * 2; g.b_pm = 0; return g; }

struct StaticOrder {
    int nM, nN, nwg, G, c;
    __host__ __device__ void init(int M, int N, int G_, int c_) { nM = M / BM; nN = N / BM; nwg = nM * nN; G = G_; c = c_; }
    __host__ __device__ bool next(int i, Unit& u) const {
        const long L = (long)i * G + c; if (L >= nwg) return false;
        int wgid = (int)L; { const int q = nwg / NXCD, r = nwg % NXCD, xcd = wgid % NXCD, off = wgid / NXCD; wgid = (xcd < r ? xcd * (q + 1) : r * (q + 1) + (xcd - r) * q) + off; }
        const int nig = WGM * nN, gid = wgid / nig, fm = gid * WGM, gsz = (nM - fm) < WGM ? (nM - fm) : WGM;
        u.pm = fm + ((wgid % nig) % gsz); u.pn = (wgid % nig) / gsz; u.kh = 0; return true;
    }
    __device__ __forceinline__ void a_ready(const Unit&) const {}
    __device__ __forceinline__ void done(const Unit&) const {}
};
struct SplitOrder : StaticOrder {
    __host__ __device__ bool next(int i, Unit& u) const { if (!StaticOrder::next(i >> 1, u)) return false; u.kh = i & 1; return true; }
};
struct KSplitOrder { int nN, ns, G, c;
    __host__ __device__ void init(int N, int nsplit, int G_, int c_) { nN = N / BM; ns = nsplit; G = G_; c = c_; }
    __host__ __device__ bool next(int i, Unit& u) const { const long L = (long)i * G + c; if (L >= (long)nN * ns) return false; u.pm = 0; u.pn = (int)(L / ns); u.kh = (int)(L % ns); return true; }
    __device__ __forceinline__ void a_ready(const Unit&) const {}
    __device__ __forceinline__ void done(const Unit&) const {}
};
__device__ __forceinline__ unsigned cvt_pk_bf16(float lo, float hi) { unsigned r; asm volatile("v_cvt_pk_bf16_f32 %0, %1, %2" : "=v"(r) : "v"(lo), "v"(hi)); return r; }
template <class Epi, class Sched>
__device__ __forceinline__ void gemm_phase(PG8_LAS unsigned char* lds, const Gemm g, const Sched& S, const Epi& E) {
    const int tid = threadIdx.x, wid = __builtin_amdgcn_readfirstlane(tid >> 6), lane = tid & 63, wr = wid >> 2, wc = wid & 3, fr = lane & 15, fq = lane >> 4;
    const int K = g.K, LDA = g.lda, LDB = g.ldb, nt = K / BK;
    unsigned voffA[2], voffB[2];
#pragma unroll
    for (int i = 0; i < 2; ++i) { int R, C; stage_rc(tid * 16 + i * 8192, R, C); const int Rb = Epi::PERM ? ((R & ~31) + perm32(R & 31)) : R;
        voffA[i] = (unsigned)(R * LDA + C) * 2u; voffB[i] = (unsigned)(Rb * LDB + C) * 2u; }
    const size_t kstep = (size_t)(BK * 2);
    const size_t hstepA = (size_t)HALF * LDA * 2, hstepB = (size_t)HALF * LDB * 2;
    const size_t tA = g.a_tile, tB = g.b_tile, tBm = g.b_pm;
    const unsigned ldsw = (unsigned)wid * 1024u;
    const int aoff = lds_byte(wr * 64 + fr, fq * 8), boff = lds_byte(wc * 32 + fr, fq * 8);
#define PG8_SA(b, h) (((b) * 2 + (h)) * HTB)
#define PG8_SB(b, h) ((4 + (b) * 2 + (h)) * HTB)
#define PG8_STAGE(bufoff, gbase, voff) do { _Pragma("unroll") for (int _i = 0; _i < 2; ++_i) \
        __builtin_amdgcn_global_load_lds((const unsigned*)((const char*)(gbase) + (voff)[_i]), (PG8_LAS unsigned*)(lds + (bufoff) + ldsw + _i * 8192), 16, 0, 0); } while (0)
#define PG8_LDA(dst, b, h) do { _Pragma("unroll") for (int m = 0; m < 4; ++m) _Pragma("unroll") for (int k = 0; k < 2; ++k) dst[m][k] = *(const PG8_LAS bf16x8*)(lds + PG8_SA(b, h) + aoff + m * 2048 + k * 1024); } while (0)
#define PG8_LDB(dst, b, h) do { _Pragma("unroll") for (int n = 0; n < 2; ++n) _Pragma("unroll") for (int k = 0; k < 2; ++k) dst[n][k] = *(const PG8_LAS bf16x8*)(lds + PG8_SB(b, h) + boff + n * 2048 + k * 1024); } while (0)
#define PG8_MMA(ai, bj, At, Bt) do { __builtin_amdgcn_s_setprio(1); _Pragma("unroll") for (int m = 0; m < 4; ++m) _Pragma("unroll") for (int n = 0; n < 2; ++n) _Pragma("unroll") for (int k = 0; k < 2; ++k) \
        acc[ai][bj][m][n] = __builtin_amdgcn_mfma_f32_16x16x32_bf16(Bt[n][k], At[m][k], acc[ai][bj][m][n], 0, 0, 0); __builtin_amdgcn_s_setprio(0); } while (0)
#define PG8_WAIT_V(n) asm volatile("s_waitcnt vmcnt(" #n ")" ::: "memory")
#define PG8_WAIT_L(n) asm volatile("s_waitcnt lgkmcnt(" #n ")" ::: "memory")
#define PG8_BAR __builtin_amdgcn_s_barrier()
#define PG8_SCHED __builtin_amdgcn_sched_barrier(0)
    Unit cur, nxt; int ui = 0;
    if (!S.next(0, cur)) return;
    f32x4 acc[2][2][4][2];
#pragma unroll
    for (int a = 0; a < 2; ++a)
#pragma unroll
        for (int b = 0; b < 2; ++b)
#pragma unroll
            for (int m = 0; m < 4; ++m)
#pragma unroll
                for (int n = 0; n < 2; ++n) acc[a][b][m][n] = (f32x4){0.f, 0.f, 0.f, 0.f};
    bf16x8 At[4][2], B0[2][2], B1[2][2];
    const char* cA = (const char*)g.A + (size_t)cur.pm * tA + (size_t)cur.kh * K * 2; const char* cB = (const char*)g.Bt + (size_t)cur.pn * tB + (size_t)cur.pm * tBm + (size_t)cur.kh * K * 2;
    S.a_ready(cur);
    PG8_STAGE(PG8_SB(0, 0), cB, voffB); PG8_STAGE(PG8_SB(0, 1), cB + hstepB, voffB); PG8_STAGE(PG8_SA(0, 0), cA, voffA); PG8_STAGE(PG8_SA(0, 1), cA + hstepA, voffA);
    if (wr == 1) PG8_BAR;
    PG8_WAIT_V(2); PG8_BAR;
    PG8_STAGE(PG8_SB(1, 0), cB + kstep, voffB); PG8_STAGE(PG8_SA(1, 0), cA + kstep, voffA); PG8_STAGE(PG8_SB(1, 1), cB + hstepB + kstep, voffB);
    PG8_WAIT_V(6); PG8_BAR;
    for (;;) {
        const bool has_next = S.next(ui + 1, nxt);
        const char* nA = has_next ? (const char*)g.A + (size_t)nxt.pm * tA + (size_t)nxt.kh * K * 2 : cA; const char* nB = has_next ? (const char*)g.Bt + (size_t)nxt.pn * tB + (size_t)nxt.pm * tBm + (size_t)nxt.kh * K * 2 : cB;
        for (int t = 0; t < nt; t += 2) {
            const bool last = (t == nt - 2);
            const char* a1 = cA + (size_t)(t + 1) * kstep;
            const char* a2 = last ? nA : cA + (size_t)(t + 2) * kstep; const char* b2 = last ? nB : cB + (size_t)(t + 2) * kstep;
            const char* a3 = a2 + kstep; const char* b3 = b2 + kstep;
            if (last && has_next) S.a_ready(nxt);
            PG8_LDB(B0, 0, 0); PG8_LDB(B1, 0, 1); PG8_SCHED; PG8_LDA(At, 0, 0); PG8_STAGE(PG8_SA(1, 1), a1 + hstepA, voffA);
            PG8_WAIT_V(8); PG8_WAIT_L(0); PG8_BAR; PG8_MMA(0, 0, At, B0); PG8_MMA(0, 1, At, B1); PG8_BAR; PG8_SCHED;
            PG8_LDA(At, 0, 1); PG8_STAGE(PG8_SB(0, 0), b2, voffB); PG8_STAGE(PG8_SB(0, 1), b2 + hstepB, voffB); PG8_STAGE(PG8_SA(0, 0), a2, voffA);
            PG8_WAIT_V(8); PG8_WAIT_L(0); PG8_BAR; PG8_MMA(1, 0, At, B0); PG8_MMA(1, 1, At, B1); PG8_BAR; PG8_SCHED;
            PG8_LDB(B0, 1, 0); PG8_LDB(B1, 1, 1); PG8_SCHED; PG8_LDA(At, 1, 0); PG8_STAGE(PG8_SA(0, 1), a2 + hstepA, voffA);
            PG8_WAIT_V(8); PG8_WAIT_L(0); PG8_BAR; PG8_MMA(0, 0, At, B0); PG8_MMA(0, 1, At, B1); PG8_BAR; PG8_SCHED;
            PG8_LDA(At, 1, 1); PG8_STAGE(PG8_SB(1, 0), b3, voffB); PG8_STAGE(PG8_SB(1, 1), b3 + hstepB, voffB); PG8_STAGE(PG8_SA(1, 0), a3, voffA);
            PG8_WAIT_V(8); PG8_WAIT_L(0); PG8_BAR; PG8_MMA(1, 0, At, B0); PG8_MMA(1, 1, At, B1); PG8_BAR; PG8_SCHED;
        }
        if (wr == 0) PG8_BAR;
        if constexpr (Epi::HAS_MID) { if (cur.kh == 0) E.mid(acc, cur, wr, wc, fr, fq); else E(acc, cur, wr, wc, fr, fq); } else E(acc, cur, wr, wc, fr, fq);
        if (!has_next) break;
        if (!(Epi::HAS_MID && nxt.kh == 1)) {
#pragma unroll
        for (int a = 0; a < 2; ++a)
#pragma unroll
            for (int b = 0; b < 2; ++b)
#pragma unroll
                for (int m = 0; m < 4; ++m)
#pragma unroll
                    for (int n = 0; n < 2; ++n) acc[a][b][m][n] = (f32x4){0.f, 0.f, 0.f, 0.f};
        }
        cur = nxt; cA = nA; cB = nB; ++ui;
        if (wr == 1) PG8_BAR;
    }
    PG8_WAIT_V(0);
    PG8_BAR;
#undef PG8_SA
#undef PG8_SB
#undef PG8_STAGE
#undef PG8_LDA
#undef PG8_LDB
#undef PG8_MMA
#undef PG8_WAIT_V
#undef PG8_WAIT_L
#undef PG8_BAR
#undef PG8_SCHED
}
}

using pg8::f32x4; using pg8::u32x4; using pg8::bf16x8; using pg8::bf16_t; using pg8::cvt_pk_bf16; using pg8::Unit;
#define LAS __attribute__((address_space(3)))
typedef unsigned u32x2 __attribute__((ext_vector_type(2)));
typedef int i32x4 __attribute__((ext_vector_type(4)));

constexpr int T_P = 16384, T_ALL = 16512, MP = 16640, DM = 1024, MODW = 6144;
constexpr float EPS = 1e-6f;
constexpr size_t KiB = 1024, MiB = 1024 * 1024;
constexpr size_t WS_MOD = 1 * MiB, WS_CS = 4608 * KiB, WS_KBLK = 5 * MiB, WS_WINT = 6 * MiB, WS_WCGT = 14 * MiB, WS_WOUTT = 16 * MiB, WS_WQT = 18 * MiB,
    WS_R1 = 22 * MiB, WS_R2 = WS_R1 + 33280 * KiB, WS_R3 = WS_R2 + 66560 * KiB, WS_R4 = WS_R3 + 33280 * KiB, WS_R5 = WS_R4 + 16640 * KiB, WS_END = WS_R3 + 133120 * KiB;
constexpr size_t OUT_YS = (size_t)T_P * DM, OUT_CSP = OUT_YS + 128 * 1024, OUT_CSS = OUT_CSP + 8 * 30 * 512, OUT_GV = OUT_CSS + 128 * 30 * 512;
constexpr int LDS_MAIN = 512 * 136 * 2, LDS_BYTES = LDS_MAIN + 16;
constexpr int NPH = 15;
constexpr size_t MODP_STRIDE = (size_t)136 * 6144;
constexpr size_t WS_CNT2 = 16384, WS_CTL_BYTES = 16384 + 8 * 256, WS_EID = 6 * MiB, WS_GATE = 11 * MiB, WS_PART = WS_R3, WS_SUMSQ = WS_R3 + 66 * MiB, WS_CF = WS_R3 + 68 * MiB, WS_WQN = WS_R3 + 12 * MiB, WS_MODP = WS_R2;
#ifndef PH_MASK
#define PH_MASK 0x7FFF
#endif
#define PHON(k) (((PH_MASK) >> (k)) & 1)
#ifndef REPEAT_MASK
#define REPEAT_MASK 0
#endif
#define REPS(k) (1 + (((REPEAT_MASK) >> (k)) & 1))

enum { I_x_prompt = 0, I_x_sample = 1, I_state_conv = 2, I_c_prompt = 3, I_c_sample = 4, I_w_ada = 5, I_b_ada = 6, I_g_mix = 7, I_w_in = 8, I_w_dw = 9, I_b_dw = 10, I_g_cn = 11, I_b_cn = 12, I_w_conv_out = 13, I_g_v = 14, I_b_v = 15, I_w_s = 16, I_b_s = 17, I_w_gmlp_out = 18, I_w_out = 19, I_g_ffn = 20, I_w_q = 21, I_k1 = 22, I_k2 = 23, I_u_tab = 24, I_v_tab = 25, I_g_final = 26 };
struct Params { const float* in[27]; float* out; unsigned char* ws; int ph_lo, ph_hi; };
template <int I> __device__ __forceinline__ const float* ldarg() { const char* ka = (const char*)__builtin_amdgcn_kernarg_segment_ptr(); unsigned long long p;
    asm volatile("s_load_dwordx2 %0, %1, %2\n\ts_waitcnt lgkmcnt(0)" : "=s"(p) : "s"(ka), "i"(I * 8)); return (const float*)p; }
#define ARG(name) ldarg<I_##name>()


__device__ __forceinline__ float wave_sum(float v) {
#pragma unroll
    for (int o = 1; o < 64; o <<= 1) v += __shfl_xor(v, o);
    return v;
}
__device__ __forceinline__ float sigm(float x) { return 1.0f / (1.0f + __expf(-x)); }
__device__ __forceinline__ float bf_lo(unsigned w) { return __uint_as_float(w << 16); }
__device__ __forceinline__ float bf_hi(unsigned w) { return __uint_as_float(w & 0xffff0000u); }
__device__ __forceinline__ u32x4 pack8(f32x4 a, f32x4 b) { u32x4 w; w.x = cvt_pk_bf16(a[0], a[1]); w.y = cvt_pk_bf16(a[2], a[3]); w.z = cvt_pk_bf16(b[0], b[1]); w.w = cvt_pk_bf16(b[2], b[3]); return w; }
__device__ __forceinline__ int modrow(int r) { return r < T_P ? (r >> 11) : (8 + r - T_P); }
#define LDS_WAIT() asm volatile("s_waitcnt lgkmcnt(0)" ::: "memory")

struct EpiMod {
    static constexpr bool PERM = false, AFTER_DRAIN = false, HAS_MID = false;
    float* mod; const float* bias;
    __device__ __forceinline__ void operator()(const f32x4 (&acc)[2][2][4][2], const Unit& u, int wr, int wc, int fr, int fq) const {
        const int row0 = u.pm * 256 + wr * 64 + fr, col0 = u.pn * 256 + wc * 32 + 4 * fq;
#pragma unroll
        for (int ai = 0; ai < 2; ++ai)
#pragma unroll
            for (int m = 0; m < 4; ++m) { const int r = row0 + ai * 128 + m * 16;
                if (r < 136) {
#pragma unroll
                    for (int bj = 0; bj < 2; ++bj)
#pragma unroll
                        for (int n = 0; n < 2; ++n) { const int c = col0 + bj * 128 + n * 16; *(f32x4*)(mod + (size_t)u.kh * MODP_STRIDE + (size_t)r * MODW + c) = acc[ai][bj][m][n]; } } }
    }
};
struct EpiZ {
    static constexpr bool PERM = true, AFTER_DRAIN = false, HAS_MID = false;
    float* a_buf; bf16_t* u_buf; float* v_buf; bf16_t* ga; bf16_t* gb;
    __device__ __forceinline__ void operator()(const f32x4 (&acc)[2][2][4][2], const Unit& u, int wr, int wc, int fr, int fq) const {
        const int row0 = u.pm * 256 + wr * 64 + fr, cw = wc * 32 + 8 * fq, pn = u.pn;
        if (pn < 4) {
#pragma unroll
            for (int ai = 0; ai < 2; ++ai)
#pragma unroll
                for (int m = 0; m < 4; ++m) { const size_t r = row0 + ai * 128 + m * 16; float* dst = a_buf + r * 512 + pn * 128 + cw;
#pragma unroll
                    for (int n = 0; n < 2; ++n) { const f32x4 l = acc[ai][0][m][n], g = acc[ai][1][m][n]; f32x4 o;
#pragma unroll
                        for (int j = 0; j < 4; ++j) o[j] = l[j] * sigm(g[j]);
                        *(f32x4*)(dst + 4 * n) = o; } }
        } else if (pn < 6) {
#pragma unroll
            for (int ai = 0; ai < 2; ++ai)
#pragma unroll
                for (int m = 0; m < 4; ++m) { const size_t r = row0 + ai * 128 + m * 16;
#pragma unroll
                    for (int bj = 0; bj < 2; ++bj) *(u32x4*)(u_buf + r * 512 + (pn - 4) * 256 + bj * 128 + cw) = pack8(acc[ai][bj][m][0], acc[ai][bj][m][1]); }
        } else if (pn < 8) {
#pragma unroll
            for (int ai = 0; ai < 2; ++ai)
#pragma unroll
                for (int m = 0; m < 4; ++m) { const size_t r = row0 + ai * 128 + m * 16;
#pragma unroll
                    for (int bj = 0; bj < 2; ++bj) { float* dst = v_buf + r * 512 + (pn - 6) * 256 + bj * 128 + cw; *(f32x4*)dst = acc[ai][bj][m][0]; *(f32x4*)(dst + 4) = acc[ai][bj][m][1]; } }
        } else {
            bf16_t* gdst = pn < 12 ? ga : gb; const int cb = ((pn - 8) & 3) * 256;
#pragma unroll
            for (int ai = 0; ai < 2; ++ai)
#pragma unroll
                for (int m = 0; m < 4; ++m) { const size_t r = row0 + ai * 128 + m * 16;
#pragma unroll
                    for (int bj = 0; bj < 2; ++bj) { f32x4 s0, s1;
#pragma unroll
                        for (int j = 0; j < 4; ++j) { s0[j] = sigm(acc[ai][bj][m][0][j]); s1[j] = sigm(acc[ai][bj][m][1][j]); }
                        *(u32x4*)(gdst + r * 1024 + cb + bj * 128 + cw) = pack8(s0, s1); } }
        }
    }
};
struct EpiM {
    static constexpr bool PERM = true, AFTER_DRAIN = false, HAS_MID = true;
    const bf16_t* ga; const bf16_t* gb; bf16_t* m_buf;
    __device__ __forceinline__ void mid(f32x4 (&acc)[2][2][4][2], const Unit& u, int wr, int wc, int fr, int fq) const {
        const int row0 = u.pm * 256 + wr * 64 + fr, cw = wc * 32 + 8 * fq;
#pragma unroll
        for (int ai = 0; ai < 2; ++ai)
#pragma unroll
            for (int m = 0; m < 4; ++m) { const size_t r = row0 + ai * 128 + m * 16;
#pragma unroll
                for (int bj = 0; bj < 2; ++bj) { const size_t o = r * 1024 + u.pn * 256 + bj * 128 + cw; const u32x4 A = *(const u32x4*)(ga + o), B = *(const u32x4*)(gb + o);
#pragma unroll
                    for (int w = 0; w < 4; ++w) { const float rl = bf_lo(A[w]) * __builtin_amdgcn_rcpf(fmaxf(bf_lo(B[w]), 1e-30f)), rh = bf_hi(A[w]) * __builtin_amdgcn_rcpf(fmaxf(bf_hi(B[w]), 1e-30f));
                        acc[ai][bj][m][w >> 1][(w & 1) * 2] *= rl; acc[ai][bj][m][w >> 1][(w & 1) * 2 + 1] *= rh; } }
                asm volatile("" : "+v"(acc[ai][0][m][0]), "+v"(acc[ai][0][m][1]), "+v"(acc[ai][1][m][0]), "+v"(acc[ai][1][m][1]));
                asm volatile("" ::: "memory"); }
    }
    __device__ __forceinline__ void operator()(const f32x4 (&acc)[2][2][4][2], const Unit& u, int wr, int wc, int fr, int fq) const {
        const int row0 = u.pm * 256 + wr * 64 + fr, cw = wc * 32 + 8 * fq;
#pragma unroll
        for (int ai = 0; ai < 2; ++ai)
#pragma unroll
            for (int m = 0; m < 4; ++m) { const size_t r = row0 + ai * 128 + m * 16;
#pragma unroll
                for (int bj = 0; bj < 2; ++bj) { const size_t o = r * 1024 + u.pn * 256 + bj * 128 + cw; const u32x4 B = *(const u32x4*)(gb + o); f32x4 v0 = acc[ai][bj][m][0], v1 = acc[ai][bj][m][1];
                    v0[0] *= bf_lo(B[0]); v0[1] *= bf_hi(B[0]); v0[2] *= bf_lo(B[1]); v0[3] *= bf_hi(B[1]); v1[0] *= bf_lo(B[2]); v1[1] *= bf_hi(B[2]); v1[2] *= bf_lo(B[3]); v1[3] *= bf_hi(B[3]);
                    *(u32x4*)(m_buf + o) = pack8(v0, v1); } }
    }
};
struct EpiX1 {
    static constexpr bool PERM = false, AFTER_DRAIN = false, HAS_MID = false;
    const float* xp; const float* xs; const float* mod; float* out;
    __device__ __forceinline__ void operator()(const f32x4 (&acc)[2][2][4][2], const Unit& u, int wr, int wc, int fr, int fq) const {
        const int row0 = u.pm * 256 + wr * 64 + fr, col0 = u.pn * 256 + wc * 32 + 4 * fq;
#pragma unroll
        for (int ai = 0; ai < 2; ++ai)
#pragma unroll
            for (int m = 0; m < 4; ++m) { const int r = row0 + ai * 128 + m * 16;
                if (r < T_ALL) { const float* xr = r < T_P ? xp + (size_t)r * DM : xs + (size_t)(r - T_P) * DM; const float* gt = mod + (size_t)modrow(r) * MODW + 2048; float* o = out + (size_t)r * DM;
#pragma unroll
                    for (int bj = 0; bj < 2; ++bj)
#pragma unroll
                        for (int n = 0; n < 2; ++n) { const int c = col0 + bj * 128 + n * 16; *(f32x4*)(o + c) = *(const f32x4*)(xr + c) + *(const f32x4*)(gt + c) * acc[ai][bj][m][n]; } } }
    }
};
struct EpiQ {
    static constexpr bool PERM = true, AFTER_DRAIN = false, HAS_MID = false;
    bf16_t* q;
    __device__ __forceinline__ void operator()(const f32x4 (&acc)[2][2][4][2], const Unit& u, int wr, int wc, int fr, int fq) const {
        const int row0 = u.pm * 256 + wr * 64 + fr, cw = wc * 32 + 8 * fq;
#pragma unroll
        for (int ai = 0; ai < 2; ++ai)
#pragma unroll
            for (int m = 0; m < 4; ++m) { const size_t r = row0 + ai * 128 + m * 16;
#pragma unroll
                for (int bj = 0; bj < 2; ++bj) *(u32x4*)(q + r * 2048 + u.pn * 256 + bj * 128 + cw) = pack8(acc[ai][bj][m][0], acc[ai][bj][m][1]); }
    }
};
struct EpiS {
    static constexpr bool PERM = false, AFTER_DRAIN = false, HAS_MID = false;
    float* sc;
    __device__ __forceinline__ void operator()(const f32x4 (&acc)[2][2][4][2], const Unit& u, int wr, int wc, int fr, int fq) const {
        const int row0 = u.pm * 256 + wr * 64 + fr, col0 = wc * 32 + 4 * fq;
#pragma unroll
        for (int ai = 0; ai < 2; ++ai)
#pragma unroll
            for (int m = 0; m < 4; ++m) { const size_t r = row0 + ai * 128 + m * 16;
#pragma unroll
                for (int bj = 0; bj < 2; ++bj)
#pragma unroll
                    for (int n = 0; n < 2; ++n) *(f32x4*)(sc + (r >> 5) * 8192 + (size_t)((col0 + n * 16) >> 2) * 256 + (bj * 32 + (r & 31)) * 4) = acc[ai][bj][m][n]; }
    }
};

struct EpiW {
    static constexpr bool PERM = true, AFTER_DRAIN = false, HAS_MID = false;
    bf16_t* w;
    __device__ __forceinline__ void operator()(const f32x4 (&acc)[2][2][4][2], const Unit& u, int wr, int wc, int fr, int fq) const {
        const int row0 = u.pm * 256 + wr * 64 + fr, cw = wc * 32 + 8 * fq;
#pragma unroll
        for (int ai = 0; ai < 2; ++ai)
#pragma unroll
            for (int m = 0; m < 4; ++m) { const size_t r = row0 + ai * 128 + m * 16;
#pragma unroll
                for (int bj = 0; bj < 2; ++bj) *(u32x4*)(w + r * 1024 + u.pn * 256 + bj * 128 + cw) = pack8(acc[ai][bj][m][0], acc[ai][bj][m][1]); }
    }
};
struct EpiS2 {
    static constexpr bool PERM = false, AFTER_DRAIN = false, HAS_MID = false;
    float* sc;
    __device__ __forceinline__ void operator()(const f32x4 (&acc)[2][2][4][2], const Unit& u, int wr, int wc, int fr, int fq) const {
        float* base = sc + (size_t)(u.pm * 8 + u.pn) * 65536; const int tl0 = wr * 64 + fr, j0 = wc * 32 + 4 * fq;
#pragma unroll
        for (int ai = 0; ai < 2; ++ai)
#pragma unroll
            for (int m = 0; m < 4; ++m) { const int tl = tl0 + ai * 128 + m * 16;
#pragma unroll
                for (int bj = 0; bj < 2; ++bj)
#pragma unroll
                    for (int n = 0; n < 2; ++n) *(f32x4*)(base + (size_t)((j0 + n * 16) >> 2) * 2048 + bj * 1024 + tl * 4) = acc[ai][bj][m][n]; }
    }
};
__device__ __forceinline__ int winmap(int n) { if (n < 512) return ((n >> 7) << 8) + (n & 127); if (n < 1024) { const int ch = n - 512; return ((ch >> 7) << 8) + 128 + (ch & 127); } return n; }
__device__ __forceinline__ void transpose_item(const float* __restrict__ W, int N, bf16_t* WT, int ldt, int koff, bool remap, LAS float* scr, int item, int lane) {
    const int nblk = N >> 5, kb = item / nblk, nb = item - kb * nblk, k0 = 64 * kb, n0 = 32 * nb;
#pragma unroll 16
    for (int i = 0; i < 32; ++i) { const int kk = 2 * i + (lane >> 5); scr[kk * 33 + (lane & 31)] = W[(size_t)(k0 + kk) * N + n0 + (lane & 31)]; }
    LDS_WAIT();
    const int c = lane & 7;
#pragma unroll
    for (int j = 0; j < 4; ++j) { const int n = (lane >> 3) + 8 * j; const LAS float* s = scr + (8 * c) * 33 + n;
        u32x4 o; o.x = cvt_pk_bf16(s[0 * 33], s[1 * 33]); o.y = cvt_pk_bf16(s[2 * 33], s[3 * 33]); o.z = cvt_pk_bf16(s[4 * 33], s[5 * 33]); o.w = cvt_pk_bf16(s[6 * 33], s[7 * 33]);
        int nd = n0 + n; if (remap) nd = winmap(nd);
        *(u32x4*)(WT + (size_t)nd * ldt + koff + k0 + 8 * c) = o; }
    LDS_WAIT();
}
template <int PART> __device__ __forceinline__ void phase0(const Params& P, PG8_LAS unsigned char* lds, int lane, int wave, int gw, int NGW) {
    LAS float* scr = (LAS float*)(lds + wave * 8704);
    unsigned char* ws = P.ws;
    constexpr int I_ADA = 16 * 192, I_IN = 16 * 128, I_CO = 8 * 32, I_GO = 8 * 32, I_OUT = 16 * 32, I_Q = 16 * 64, I_KB = 256, I_CS = 256;
    if constexpr (PART == 0) {
        constexpr int I_QN = 1024;
        for (int it = gw; it < I_ADA + I_KB + I_CS + I_QN; it += NGW) {
            int r = it;
            if (r < I_ADA) { transpose_item(ARG(w_ada), MODW, (bf16_t*)(ws + WS_R3), 1024, 0, false, scr, r, lane); continue; } r -= I_ADA;
            if (r < I_KB) {
                const int n = r, c0 = 4 * lane; f32x4 v = (f32x4){0.f, 0.f, 0.f, 0.f};
                if (n < 128 && c0 < 128) v = *(const f32x4*)(ARG(k1) + n * 128 + c0);
                if (n >= 128 && c0 >= 128) v = *(const f32x4*)(ARG(k2) + (n - 128) * 128 + c0 - 128);
                u32x2 o; o.x = cvt_pk_bf16(v[0], v[1]); o.y = cvt_pk_bf16(v[2], v[3]);
                *(u32x2*)((bf16_t*)(ws + WS_KBLK) + n * 256 + c0) = o; continue; } r -= I_KB;
            if (r >= I_CS) { r -= I_CS; const float* src = ARG(w_q) + (size_t)r * 2048; bf16_t* dst = (bf16_t*)(ws + WS_WQN) + (size_t)r * 2048;
#pragma unroll
                for (int j = 0; j < 8; ++j) { const f32x4 v = *(const f32x4*)(src + 4 * lane + 256 * j); u32x2 o; o.x = cvt_pk_bf16(v[0], v[1]); o.y = cvt_pk_bf16(v[2], v[3]); *(u32x2*)(dst + 4 * lane + 256 * j) = o; }
                continue; }
            {
                const float* src = r < 8 ? ARG(c_prompt) + (size_t)r * DM : (r < 136 ? ARG(c_sample) + (size_t)(r - 8) * DM : nullptr);
#pragma unroll
                for (int j = 0; j < 4; ++j) { const int c0 = 4 * lane + 256 * j; f32x4 v = (f32x4){0.f, 0.f, 0.f, 0.f};
                    if (src) { v = *(const f32x4*)(src + c0);
#pragma unroll
                        for (int e = 0; e < 4; ++e) v[e] = v[e] * sigm(v[e]); }
                    u32x2 o; o.x = cvt_pk_bf16(v[0], v[1]); o.y = cvt_pk_bf16(v[2], v[3]);
                    *(u32x2*)((bf16_t*)(ws + WS_CS) + (size_t)r * DM + c0) = o; }
            }
        }
    } else {
        for (int it = gw; it < I_IN + I_CO + I_GO + I_OUT; it += NGW) {
            int r = it;
            if (r < I_IN) { transpose_item(ARG(w_in), 4096, (bf16_t*)(ws + WS_WINT), 1024, 0, true, scr, r, lane); continue; } r -= I_IN;
            if (r < I_CO) { transpose_item(ARG(w_conv_out), 1024, (bf16_t*)(ws + WS_WCGT), 1024, 0, false, scr, r, lane); continue; } r -= I_CO;
            if (r < I_GO) { transpose_item(ARG(w_gmlp_out), 1024, (bf16_t*)(ws + WS_WCGT), 1024, 512, false, scr, r, lane); continue; } r -= I_GO;
            transpose_item(ARG(w_out), 1024, (bf16_t*)(ws + WS_WOUTT), 1024, 0, false, scr, r, lane);
        }
    }
}
struct WaveItems { int q, extra, stride, nk; int gw, NGW;
    __device__ __forceinline__ WaveItems(int NIT, int gw_, int NGW_) : gw(gw_), NGW(NGW_) { q = NIT / NGW_; extra = NIT - q * NGW_; stride = extra ? NGW_ / extra : 1; nk = q + ((extra && gw_ % stride == 0 && gw_ / stride < extra) ? 1 : 0); }
    __device__ __forceinline__ int item(int k) const { return k < q ? gw + k * NGW : q * NGW + gw / stride; } };
template <bool SECOND> __device__ __forceinline__ void norm_rows(const Params& P, bf16_t* dst, int lane, int gw, int NGW) {
    const float* mod = SECOND ? (const float*)(P.ws + WS_MOD) : (const float*)(P.ws + WS_MODP); const float* bada = ARG(b_ada);
    const float* g = SECOND ? ARG(g_ffn) : ARG(g_mix); const float* xp_ = ARG(x_prompt); const float* xs_ = ARG(x_sample);
    const WaveItems wi(T_ALL / 4, gw, NGW);
    for (int k_ = 0; k_ < wi.nk; ++k_) { const int rb = wi.item(k_) * 4;
        f32x4 v[4][4]; float ss[4];
#pragma unroll
        for (int i = 0; i < 4; ++i) { const int r = rb + i;
            const float* src = SECOND ? P.out + (size_t)r * DM : (r < T_P ? xp_ + (size_t)r * DM : xs_ + (size_t)(r - T_P) * DM); ss[i] = 0.f;
#pragma unroll
            for (int j = 0; j < 4; ++j) { v[i][j] = __builtin_nontemporal_load((const f32x4*)(src + 4 * lane + 256 * j)); ss[i] += (v[i][j][0] * v[i][j][0] + v[i][j][1] * v[i][j][1]) + (v[i][j][2] * v[i][j][2] + v[i][j][3] * v[i][j][3]); } }
#pragma unroll
        for (int o = 1; o < 64; o <<= 1) {
#pragma unroll
            for (int i = 0; i < 4; ++i) ss[i] += __shfl_xor(ss[i], o); }
#pragma unroll
        for (int i = 0; i < 4; ++i) { const int r = rb + i; const float rstd = rsqrtf(ss[i] * (1.0f / DM) + EPS);
            const float* mr = mod + (size_t)modrow(r) * MODW; const float* sh = mr + (SECOND ? 3072 : 0); const float* sc = mr + (SECOND ? 4096 : 1024);
            bf16_t* orow = dst + (size_t)r * DM;
#pragma unroll
            for (int j = 0; j < 4; ++j) { const int c0 = 4 * lane + 256 * j; const f32x4 gg = *(const f32x4*)(g + c0);
                f32x4 s1 = *(const f32x4*)(sc + c0), s0 = *(const f32x4*)(sh + c0);
                if (!SECOND) { s1 += *(const f32x4*)(sc + MODP_STRIDE + c0) + *(const f32x4*)(bada + 1024 + c0); s0 += *(const f32x4*)(sh + MODP_STRIDE + c0) + *(const f32x4*)(bada + c0); }
                const f32x4 y = v[i][j] * rstd * gg * (1.0f + s1) + s0;
                u32x2 o; o.x = cvt_pk_bf16(y[0], y[1]); o.y = cvt_pk_bf16(y[2], y[3]); *(u32x2*)(orow + c0) = o; } }
    }
}
__device__ __forceinline__ void ln512(f32x4& a0, f32x4& a1, const f32x4 g0, const f32x4 g1, const f32x4 b0, const f32x4 b1) {
    const float s = (a0[0] + a0[1]) + (a0[2] + a0[3]) + (a1[0] + a1[1]) + (a1[2] + a1[3]);
    const float mean = wave_sum(s) * (1.0f / 512.0f);
    a0 = a0 - mean; a1 = a1 - mean;
    const float q = (a0[0] * a0[0] + a0[1] * a0[1]) + (a0[2] * a0[2] + a0[3] * a0[3]) + (a1[0] * a1[0] + a1[1] * a1[1]) + (a1[2] * a1[2] + a1[3] * a1[3]);
    const float rstd = rsqrtf(wave_sum(q) * (1.0f / 512.0f) + EPS);
    a0 = a0 * rstd * g0 + b0; a1 = a1 * rstd * g1 + b1;
}
__device__ __forceinline__ void conv_tile(const Params& P, PG8_LAS unsigned char* lds, int item, int half, int tid, int lane, int wave) {
    const int b = item >> 4, ck = item & 15, t0 = ck * 128 + 64 * half; const size_t rbase = (size_t)b * 2048;
    const float* a_buf = (const float*)(P.ws + WS_R3); bf16_t* acat = (bf16_t*)(P.ws + WS_R1);
    LAS f32x4* wl = (LAS f32x4*)lds;
    for (int i = tid; i < 31 * 128; i += 512) wl[i] = ((const f32x4*)ARG(w_dw))[i];
    __syncthreads();
    const int c0 = 8 * lane;
    const float* bdp = ARG(b_dw); const float* gcp = ARG(g_cn); const float* bcp = ARG(b_cn);
    for (int g = wave; g < 16; g += 8) {
        const int p0 = t0 + 4 * g;
        f32x4 acc[4][2]; f32x4 wv[4][2];
#pragma unroll
        for (int p = 0; p < 4; ++p) { acc[p][0] = (f32x4){0.f, 0.f, 0.f, 0.f}; acc[p][1] = acc[p][0]; wv[p][0] = acc[p][0]; wv[p][1] = acc[p][0]; }
#pragma unroll 1
        for (int c = 0; c < 5; ++c) {
            f32x4 ar[8][2];
#pragma unroll
            for (int i = 0; i < 8; ++i) { const int rr = 8 * c + i, tpos = p0 - 30 + rr; ar[i][0] = (f32x4){0.f, 0.f, 0.f, 0.f}; ar[i][1] = ar[i][0];
                if (tpos >= 0 && rr < 34) { const float* ap = a_buf + (rbase + tpos) * 512 + c0; ar[i][0] = *(const f32x4*)ap; ar[i][1] = *(const f32x4*)(ap + 4); } }
#pragma unroll
            for (int i = 0; i < 8; ++i) {
                const int rr = 8 * c + i;
                f32x4 w0 = (f32x4){0.f, 0.f, 0.f, 0.f}, w1 = w0;
                if (rr <= 30) { w0 = wl[rr * 128 + 2 * lane]; w1 = wl[rr * 128 + 2 * lane + 1]; }
                wv[i & 3][0] = w0; wv[i & 3][1] = w1;
#pragma unroll
                for (int p = 0; p < 4; ++p) { acc[p][0] += wv[(i - p) & 3][0] * ar[i][0]; acc[p][1] += wv[(i - p) & 3][1] * ar[i][1]; }
            }
        }
#pragma unroll
        for (int p = 0; p < 4; ++p) { f32x4 y0 = acc[p][0] + *(const f32x4*)(bdp + c0), y1 = acc[p][1] + *(const f32x4*)(bdp + c0 + 4);
            ln512(y0, y1, *(const f32x4*)(gcp + c0), *(const f32x4*)(gcp + c0 + 4), *(const f32x4*)(bcp + c0), *(const f32x4*)(bcp + c0 + 4));
#pragma unroll
            for (int e = 0; e < 4; ++e) { y0[e] = y0[e] * sigm(y0[e]); y1[e] = y1[e] * sigm(y1[e]); }
            *(u32x4*)(acat + (rbase + p0 + p) * 1024 + c0) = pack8(y0, y1); }
    }
    if (ck == 15 && half == 1) {
        const f32x4* src = (const f32x4*)(a_buf + (rbase + 2018) * 512); f32x4* dst = (f32x4*)(P.out + OUT_CSP + (size_t)b * 30 * 512);
        for (int i = tid; i < 30 * 128; i += 512) dst[i] = src[i];
    }
    __syncthreads();
}
__device__ __forceinline__ void gmlp_tile(const Params& P, PG8_LAS unsigned char* lds, int item, int hh, int lane, int wave) {
    constexpr int VS = 136;
    const int b = item >> 4, ck = item & 15; const size_t r0 = (size_t)b * 2048 + ck * 128;
    const float* v_buf = (const float*)(P.ws + WS_R5); const bf16_t* u_buf = (const bf16_t*)(P.ws + WS_R4); bf16_t* acat = (bf16_t*)(P.ws + WS_R1);
    LAS bf16_t* VT = (LAS bf16_t*)lds;
    float gv[8], bv[8]; const float* gvp = ARG(g_v); const float* bvp = ARG(b_v); const float* bsp = ARG(b_s);
#pragma unroll
    for (int j = 0; j < 8; ++j) { gv[j] = gvp[lane + 64 * j]; bv[j] = bvp[lane + 64 * j]; }
    for (int jr = wave * 16; jr < wave * 16 + 16; jr += 8) {
        float v[8][8]; float s[8], q[8];
#pragma unroll
        for (int i = 0; i < 8; ++i) { const float* vr = v_buf + (r0 + jr + i) * 512; s[i] = 0.f;
#pragma unroll
            for (int j = 0; j < 8; ++j) { v[i][j] = vr[lane + 64 * j]; s[i] += v[i][j]; } }
#pragma unroll
        for (int o = 1; o < 64; o <<= 1) {
#pragma unroll
            for (int i = 0; i < 8; ++i) s[i] += __shfl_xor(s[i], o); }
#pragma unroll
        for (int i = 0; i < 8; ++i) { const float mean = s[i] * (1.0f / 512.0f); q[i] = 0.f;
#pragma unroll
            for (int j = 0; j < 8; ++j) { v[i][j] -= mean; q[i] += v[i][j] * v[i][j]; } }
#pragma unroll
        for (int o = 1; o < 64; o <<= 1) {
#pragma unroll
            for (int i = 0; i < 8; ++i) q[i] += __shfl_xor(q[i], o); }
#pragma unroll
        for (int i = 0; i < 8; ++i) { const float rstd = rsqrtf(q[i] * (1.0f / 512.0f) + EPS);
#pragma unroll
            for (int j = 0; j < 8; ++j) { if ((j >> 2) == hh) { const float y = v[i][j] * rstd * gv[j] + bv[j]; VT[(lane + 64 * (j & 3)) * VS + jr + i] = (bf16_t)(cvt_pk_bf16(y, 0.f) & 0xffffu); } } }
    }
    __syncthreads();
    const int hl = wave & 3, h = 4 * hh + hl, fr = lane & 15, fq = lane >> 4;
    const float* wsh = ARG(w_s) + (size_t)h * 128 * 128;
#pragma unroll 1
    for (int ii = 0; ii < 2; ++ii) { const int ibp = (wave >> 2) ? 1 + ii : 3 * ii;
        f32x4 acc[2][4];
#pragma unroll
        for (int d = 0; d < 4; ++d) { acc[0][d] = (f32x4){0.f, 0.f, 0.f, 0.f}; acc[1][d] = acc[0][d]; }
        const int i0 = 32 * ibp + fr, i1 = i0 + 16;
        u32x2 uu[2][4];
#pragma unroll
        for (int d = 0; d < 4; ++d) { const int col = h * 64 + 16 * d + 4 * fq; uu[0][d] = *(const u32x2*)(u_buf + (r0 + i0) * 512 + col); uu[1][d] = *(const u32x2*)(u_buf + (r0 + i1) * 512 + col); }
        const float bias0 = bsp[h * 128 + i0], bias1 = bsp[h * 128 + i1];
        for (int ks = 0; ks <= ibp; ++ks) {
            const int j0 = 32 * ks + 8 * fq;
            f32x4 w0 = *(const f32x4*)(wsh + i0 * 128 + j0), w1 = *(const f32x4*)(wsh + i0 * 128 + j0 + 4), x0 = *(const f32x4*)(wsh + i1 * 128 + j0), x1 = *(const f32x4*)(wsh + i1 * 128 + j0 + 4);
#pragma unroll
            for (int e = 0; e < 4; ++e) { if (j0 + e > i0) w0[e] = 0.f; if (j0 + 4 + e > i0) w1[e] = 0.f; if (j0 + e > i1) x0[e] = 0.f; if (j0 + 4 + e > i1) x1[e] = 0.f; }
            const u32x4 wp = pack8(w0, w1), xp = pack8(x0, x1); bf16x8 af0, af1; __builtin_memcpy(&af0, &wp, 16); __builtin_memcpy(&af1, &xp, 16);
#pragma unroll
            for (int d = 0; d < 4; ++d) { const bf16x8 bfr = *(const LAS bf16x8*)(VT + (hl * 64 + 16 * d + fr) * VS + j0);
                acc[0][d] = __builtin_amdgcn_mfma_f32_16x16x32_bf16(bfr, af0, acc[0][d], 0, 0, 0); acc[1][d] = __builtin_amdgcn_mfma_f32_16x16x32_bf16(bfr, af1, acc[1][d], 0, 0, 0); }
        }
#pragma unroll
        for (int z = 0; z < 2; ++z) { const int i = z ? i1 : i0; const float bias = z ? bias1 : bias0;
#pragma unroll
            for (int d = 0; d < 4; ++d) { const int col = h * 64 + 16 * d + 4 * fq; const u32x2 u2 = uu[z][d];
                const float o0 = (acc[z][d][0] + bias) * bf_lo(u2.x), o1 = (acc[z][d][1] + bias) * bf_hi(u2.x), o2 = (acc[z][d][2] + bias) * bf_lo(u2.y), o3 = (acc[z][d][3] + bias) * bf_hi(u2.y);
                u32x2 o; o.x = cvt_pk_bf16(o0, o1); o.y = cvt_pk_bf16(o2, o3); *(u32x2*)(acat + (r0 + i) * 1024 + 512 + col) = o; } }
    }
    __syncthreads();
}
__device__ __forceinline__ void sample_conv_block(const Params& P, PG8_LAS unsigned char* lds, int i, int lane, int wave) {
    const int c0 = 8 * lane; const size_t r = (size_t)T_P + i;
    const float* a_buf = (const float*)(P.ws + WS_R3); const float* scp = ARG(state_conv); const float* wdp = ARG(w_dw);
    float* css = P.out + OUT_CSS + (size_t)i * 30 * 512;
    f32x4 y0 = (f32x4){0.f, 0.f, 0.f, 0.f}, y1 = y0;
#pragma unroll
    for (int q = 0; q < 4; ++q) { const int k = wave + 8 * q;
        if (k < 30) { const float* sp = scp + ((size_t)i * 30 + k) * 512 + c0; const f32x4 s0 = *(const f32x4*)sp, s1 = *(const f32x4*)(sp + 4);
            y0 += *(const f32x4*)(wdp + k * 512 + c0) * s0; y1 += *(const f32x4*)(wdp + k * 512 + c0 + 4) * s1;
            if (k >= 1) { *(f32x4*)(css + (k - 1) * 512 + c0) = s0; *(f32x4*)(css + (k - 1) * 512 + c0 + 4) = s1; } } }
    if (wave == 6) { const f32x4 a0 = *(const f32x4*)(a_buf + r * 512 + c0), a1 = *(const f32x4*)(a_buf + r * 512 + c0 + 4);
        y0 += *(const f32x4*)(wdp + 30 * 512 + c0) * a0; y1 += *(const f32x4*)(wdp + 30 * 512 + c0 + 4) * a1;
        *(f32x4*)(css + 29 * 512 + c0) = a0; *(f32x4*)(css + 29 * 512 + c0 + 4) = a1; }
    LAS f32x4* red = (LAS f32x4*)lds;
    red[wave * 128 + 2 * lane] = y0; red[wave * 128 + 2 * lane + 1] = y1;
    __syncthreads();
    if (wave == 0) { const float* bdp = ARG(b_dw); const float* gcp = ARG(g_cn); const float* bcp = ARG(b_cn);
        f32x4 z0 = *(const f32x4*)(bdp + c0), z1 = *(const f32x4*)(bdp + c0 + 4);
#pragma unroll
        for (int w = 0; w < 8; ++w) { z0 += red[w * 128 + 2 * lane]; z1 += red[w * 128 + 2 * lane + 1]; }
        ln512(z0, z1, *(const f32x4*)(gcp + c0), *(const f32x4*)(gcp + c0 + 4), *(const f32x4*)(bcp + c0), *(const f32x4*)(bcp + c0 + 4));
#pragma unroll
        for (int e = 0; e < 4; ++e) { z0[e] = z0[e] * sigm(z0[e]); z1[e] = z1[e] * sigm(z1[e]); }
        *(u32x4*)((bf16_t*)(P.ws + WS_R1) + r * 1024 + c0) = pack8(z0, z1); }
    __syncthreads();
}
__device__ __forceinline__ void sample_item(const Params& P, int s, int lane) {
    const int i = s >> 1, c0 = 8 * lane; const size_t r = (size_t)T_P + i;
    bf16_t* acat = (bf16_t*)(P.ws + WS_R1);
    if ((s & 1) == 0) {
        const float* a_buf = (const float*)(P.ws + WS_R3);
        const float* bdp = ARG(b_dw); const float* scp = ARG(state_conv); const float* wdp = ARG(w_dw); const float* gcp = ARG(g_cn); const float* bcp = ARG(b_cn);
        f32x4 y0 = *(const f32x4*)(bdp + c0), y1 = *(const f32x4*)(bdp + c0 + 4);
        float* css = P.out + OUT_CSS + (size_t)i * 30 * 512;
        #pragma unroll 6
        for (int k = 0; k < 30; ++k) { const float* sp = scp + ((size_t)i * 30 + k) * 512 + c0; const f32x4 s0 = *(const f32x4*)sp, s1 = *(const f32x4*)(sp + 4);
            y0 += *(const f32x4*)(wdp + k * 512 + c0) * s0; y1 += *(const f32x4*)(wdp + k * 512 + c0 + 4) * s1;
            if (k >= 1) { *(f32x4*)(css + (k - 1) * 512 + c0) = s0; *(f32x4*)(css + (k - 1) * 512 + c0 + 4) = s1; } }
        const f32x4 a0 = *(const f32x4*)(a_buf + r * 512 + c0), a1 = *(const f32x4*)(a_buf + r * 512 + c0 + 4);
        y0 += *(const f32x4*)(wdp + 30 * 512 + c0) * a0; y1 += *(const f32x4*)(wdp + 30 * 512 + c0 + 4) * a1;
        *(f32x4*)(css + 29 * 512 + c0) = a0; *(f32x4*)(css + 29 * 512 + c0 + 4) = a1;
        ln512(y0, y1, *(const f32x4*)(gcp + c0), *(const f32x4*)(gcp + c0 + 4), *(const f32x4*)(bcp + c0), *(const f32x4*)(bcp + c0 + 4));
#pragma unroll
        for (int e = 0; e < 4; ++e) { y0[e] = y0[e] * sigm(y0[e]); y1[e] = y1[e] * sigm(y1[e]); }
        *(u32x4*)(acat + r * 1024 + c0) = pack8(y0, y1);
    } else {
        const float* v_buf = (const float*)(P.ws + WS_R5); const bf16_t* u_buf = (const bf16_t*)(P.ws + WS_R4);
        f32x4 v0 = *(const f32x4*)(v_buf + r * 512 + c0), v1 = *(const f32x4*)(v_buf + r * 512 + c0 + 4);
        const float* gvp = ARG(g_v); const float* bvp = ARG(b_v);
        ln512(v0, v1, *(const f32x4*)(gvp + c0), *(const f32x4*)(gvp + c0 + 4), *(const f32x4*)(bvp + c0), *(const f32x4*)(bvp + c0 + 4));
        float* gvo = P.out + OUT_GV + (size_t)i * 512 + c0; *(f32x4*)gvo = v0; *(f32x4*)(gvo + 4) = v1;
        const int h = lane >> 3; const float w00 = ARG(w_s)[(size_t)h * 128 * 128], b0 = ARG(b_s)[h * 128];
        const u32x4 uu = *(const u32x4*)(u_buf + r * 512 + c0);
        f32x4 o0, o1;
        o0[0] = (w00 * v0[0] + b0) * bf_lo(uu.x); o0[1] = (w00 * v0[1] + b0) * bf_hi(uu.x); o0[2] = (w00 * v0[2] + b0) * bf_lo(uu.y); o0[3] = (w00 * v0[3] + b0) * bf_hi(uu.y);
        o1[0] = (w00 * v1[0] + b0) * bf_lo(uu.z); o1[1] = (w00 * v1[1] + b0) * bf_hi(uu.z); o1[2] = (w00 * v1[2] + b0) * bf_lo(uu.w); o1[3] = (w00 * v1[3] + b0) * bf_hi(uu.w);
        *(u32x4*)(acat + r * 1024 + 512 + c0) = pack8(o0, o1);
    }
}
__device__ __forceinline__ float unordkey(unsigned k) { return __uint_as_float((k & 0x80000000u) ? (k ^ 0x80000000u) : ~k); }
__device__ __forceinline__ unsigned ordkey(float f) { const unsigned u = __float_as_uint(f); return u ^ ((unsigned)((int)u >> 31) | 0x80000000u); }
#define TK_INSERT(arr, x) do { _Pragma("unroll") for (int _i = 0; _i < 16; ++_i) { const unsigned _h = arr[_i] > x ? arr[_i] : x; x = arr[_i] > x ? x : arr[_i]; arr[_i] = _h; } } while (0)
__device__ __forceinline__ void topk_phase(const Params& P, PG8_LAS unsigned char* lds, int lane, int wave, int gw, int NGW) {
    const float* scores = (const float*)(P.ws + WS_R3);
    unsigned short* eid = (unsigned short*)(P.ws + WS_EID); float* gate = (float*)(P.ws + WS_GATE);
    LAS float* lsc = (LAS float*)(lds + wave * 8704); LAS int* lix = (LAS int*)(lds + wave * 8704 + 4352);
    const int NIT_ = T_ALL / 4, extra_ = NIT_ - 2 * NGW; const bool skew_ = extra_ > 0 && extra_ * 2 <= NGW; const int stride_ = skew_ ? NGW / extra_ : 1;
    const int nk_ = skew_ ? (2 + ((gw % stride_ == 0 && gw / stride_ < extra_) ? 1 : 0)) : (gw < NIT_ ? (NIT_ - gw + NGW - 1) / NGW : 0);
    for (int k_ = 0; k_ < nk_; ++k_) { const int it = (skew_ && k_ == 2) ? 2 * NGW + gw / stride_ : gw + k_ * NGW;
        const int uu_ = it < 4096 ? (it >> 3) : 512 + ((it - 4096) >> 2), tg_ = it < 4096 ? (it & 7) : ((it - 4096) & 3), hh_ = uu_ & 7;
        const int tok0_ = (it < 4096 ? (uu_ >> 3) * 256 : T_P) + tg_ * 32;
        {
            const float* sb = scores + (size_t)uu_ * 65536 + (lane >> 5) * 1024 + (tg_ * 32 + (lane & 31)) * 4;
            unsigned s[16]; float vn[16];
#define TK_CE(a, b) do { const unsigned _h = (a) > (b) ? (a) : (b), _l = (a) > (b) ? (b) : (a); (a) = _h; (b) = _l; } while (0)
#pragma unroll
            for (int e = 0; e < 4; ++e) { const f32x4 v4 = __builtin_nontemporal_load((const f32x4*)(sb + e * 2048)); vn[4 * e] = v4[0]; vn[4 * e + 1] = v4[1]; vn[4 * e + 2] = v4[2]; vn[4 * e + 3] = v4[3]; }
#pragma unroll 1
            for (int b = 0; b < 8; ++b) { unsigned k[16];
#pragma unroll
                for (int e = 0; e < 16; ++e) k[e] = (ordkey(vn[e]) & ~127u) | (unsigned)(127 - (16 * b + e));
                if (b < 7) {
#pragma unroll
                    for (int e = 0; e < 4; ++e) { const f32x4 v4 = __builtin_nontemporal_load((const f32x4*)(sb + (4 * (b + 1) + e) * 2048)); vn[4 * e] = v4[0]; vn[4 * e + 1] = v4[1]; vn[4 * e + 2] = v4[2]; vn[4 * e + 3] = v4[3]; } }
#pragma unroll
                for (int kk = 2; kk <= 16; kk <<= 1)
#pragma unroll
                    for (int jj = kk >> 1; jj > 0; jj >>= 1)
#pragma unroll
                        for (int i2 = 0; i2 < 16; ++i2) { const int l = i2 ^ jj; if (l > i2) { if ((i2 & kk) == 0) TK_CE(k[i2], k[l]); else TK_CE(k[l], k[i2]); } }
                if (b == 0) {
#pragma unroll
                    for (int e = 0; e < 16; ++e) s[e] = k[e]; }
                else {
#pragma unroll
                    for (int e = 0; e < 16; ++e) s[e] = s[e] > k[15 - e] ? s[e] : k[15 - e];
#pragma unroll
                    for (int jj = 8; jj > 0; jj >>= 1)
#pragma unroll
                        for (int i2 = 0; i2 < 16; ++i2) { const int l = i2 ^ jj; if (l > i2) TK_CE(s[i2], s[l]); } }
            }
#undef TK_CE
#pragma unroll
            for (int a = 0; a < 16; ++a) { const int idx = 127 - (int)(s[a] & 127u); lix[lane * 17 + a] = idx; lsc[lane * 17 + a] = unordkey((s[a] & ~127u) | 64u); }
        }
        LDS_WAIT();
        {
            const int tk = lane & 31, hs = lane >> 5, tt = tok0_ + tk, h = hh_, base1 = tk * 17, base2 = (32 + tk) * 17;
            unsigned top[16];
#pragma unroll
            for (int a = 0; a < 16; ++a) top[a] = 0u;
            { const int ab = hs ? 1 : 0, a = ab >> 4, b2 = ab & 15; unsigned x = (ordkey(lsc[base1 + a] + lsc[base2 + b2]) & ~255u) | (unsigned)(255 - ab); TK_INSERT(top, x); }
            { const int ab = hs ? 3 : 2, a = ab >> 4, b2 = ab & 15; unsigned x = (ordkey(lsc[base1 + a] + lsc[base2 + b2]) & ~255u) | (unsigned)(255 - ab); TK_INSERT(top, x); }
            { const int ab = hs ? 5 : 4, a = ab >> 4, b2 = ab & 15; unsigned x = (ordkey(lsc[base1 + a] + lsc[base2 + b2]) & ~255u) | (unsigned)(255 - ab); TK_INSERT(top, x); }
            { const int ab = hs ? 7 : 6, a = ab >> 4, b2 = ab & 15; unsigned x = (ordkey(lsc[base1 + a] + lsc[base2 + b2]) & ~255u) | (unsigned)(255 - ab); TK_INSERT(top, x); }
            { const int ab = hs ? 9 : 8, a = ab >> 4, b2 = ab & 15; unsigned x = (ordkey(lsc[base1 + a] + lsc[base2 + b2]) & ~255u) | (unsigned)(255 - ab); TK_INSERT(top, x); }
            { const int ab = hs ? 11 : 10, a = ab >> 4, b2 = ab & 15; unsigned x = (ordkey(lsc[base1 + a] + lsc[base2 + b2]) & ~255u) | (unsigned)(255 - ab); TK_INSERT(top, x); }
            { const int ab = hs ? 13 : 12, a = ab >> 4, b2 = ab & 15; unsigned x = (ordkey(lsc[base1 + a] + lsc[base2 + b2]) & ~255u) | (unsigned)(255 - ab); TK_INSERT(top, x); }
            { const int ab = hs ? 15 : 14, a = ab >> 4, b2 = ab & 15; unsigned x = (ordkey(lsc[base1 + a] + lsc[base2 + b2]) & ~255u) | (unsigned)(255 - ab); TK_INSERT(top, x); }
            { const int ab = hs ? 17 : 16, a = ab >> 4, b2 = ab & 15; unsigned x = (ordkey(lsc[base1 + a] + lsc[base2 + b2]) & ~255u) | (unsigned)(255 - ab); TK_INSERT(top, x); }
            { const int ab = hs ? 19 : 18, a = ab >> 4, b2 = ab & 15; unsigned x = (ordkey(lsc[base1 + a] + lsc[base2 + b2]) & ~255u) | (unsigned)(255 - ab); TK_INSERT(top, x); }
            { const int ab = hs ? 21 : 20, a = ab >> 4, b2 = ab & 15; unsigned x = (ordkey(lsc[base1 + a] + lsc[base2 + b2]) & ~255u) | (unsigned)(255 - ab); TK_INSERT(top, x); }
            { const int ab = hs ? 23 : 22, a = ab >> 4, b2 = ab & 15; unsigned x = (ordkey(lsc[base1 + a] + lsc[base2 + b2]) & ~255u) | (unsigned)(255 - ab); TK_INSERT(top, x); }
            { const int ab = hs ? 33 : 32, a = ab >> 4, b2 = ab & 15; unsigned x = (ordkey(lsc[base1 + a] + lsc[base2 + b2]) & ~255u) | (unsigned)(255 - ab); TK_INSERT(top, x); }
            { const int ab = hs ? 35 : 34, a = ab >> 4, b2 = ab & 15; unsigned x = (ordkey(lsc[base1 + a] + lsc[base2 + b2]) & ~255u) | (unsigned)(255 - ab); TK_INSERT(top, x); }
            { const int ab = hs ? 48 : 36, a = ab >> 4, b2 = ab & 15; unsigned x = (ordkey(lsc[base1 + a] + lsc[base2 + b2]) & ~255u) | (unsigned)(255 - ab); TK_INSERT(top, x); }
            { const int ab = hs ? 50 : 49, a = ab >> 4, b2 = ab & 15; unsigned x = (ordkey(lsc[base1 + a] + lsc[base2 + b2]) & ~255u) | (unsigned)(255 - ab); TK_INSERT(top, x); }
            { const int ab = hs ? 64 : 51, a = ab >> 4, b2 = ab & 15; unsigned x = (ordkey(lsc[base1 + a] + lsc[base2 + b2]) & ~255u) | (unsigned)(255 - ab); TK_INSERT(top, x); }
            { const int ab = hs ? 66 : 65, a = ab >> 4, b2 = ab & 15; unsigned x = (ordkey(lsc[base1 + a] + lsc[base2 + b2]) & ~255u) | (unsigned)(255 - ab); TK_INSERT(top, x); }
            { const int ab = hs ? 81 : 80, a = ab >> 4, b2 = ab & 15; unsigned x = (ordkey(lsc[base1 + a] + lsc[base2 + b2]) & ~255u) | (unsigned)(255 - ab); TK_INSERT(top, x); }
            { const int ab = hs ? 97 : 96, a = ab >> 4, b2 = ab & 15; unsigned x = (ordkey(lsc[base1 + a] + lsc[base2 + b2]) & ~255u) | (unsigned)(255 - ab); TK_INSERT(top, x); }
            { const int ab = hs ? 113 : 112, a = ab >> 4, b2 = ab & 15; unsigned x = (ordkey(lsc[base1 + a] + lsc[base2 + b2]) & ~255u) | (unsigned)(255 - ab); TK_INSERT(top, x); }
            { const int ab = hs ? 144 : 128, a = ab >> 4, b2 = ab & 15; unsigned x = (ordkey(lsc[base1 + a] + lsc[base2 + b2]) & ~255u) | (unsigned)(255 - ab); TK_INSERT(top, x); }
            { const int ab = hs ? 176 : 160, a = ab >> 4, b2 = ab & 15; unsigned x = (ordkey(lsc[base1 + a] + lsc[base2 + b2]) & ~255u) | (unsigned)(255 - ab); TK_INSERT(top, x); }
            { const int ab = hs ? 208 : 192, a = ab >> 4, b2 = ab & 15; unsigned x = (ordkey(lsc[base1 + a] + lsc[base2 + b2]) & ~255u) | (unsigned)(255 - ab); TK_INSERT(top, x); }
            { const int ab = hs ? 240 : 224, a = ab >> 4, b2 = ab & 15; unsigned x = (ordkey(lsc[base1 + a] + lsc[base2 + b2]) & ~255u) | (unsigned)(255 - ab); TK_INSERT(top, x); }
#define TK_CE2(a, b) do { const unsigned _h = (a) > (b) ? (a) : (b), _l = (a) > (b) ? (b) : (a); (a) = _h; (b) = _l; } while (0)
            unsigned m[16];
#pragma unroll
            for (int e2 = 0; e2 < 16; ++e2) { const unsigned o = (unsigned)__shfl_xor((int)top[15 - e2], 32); m[e2] = top[e2] > o ? top[e2] : o; }
#pragma unroll
            for (int jj = 8; jj > 0; jj >>= 1)
#pragma unroll
                for (int i2 = 0; i2 < 16; ++i2) { const int l = i2 ^ jj; if (l > i2) TK_CE2(m[i2], m[l]); }
#undef TK_CE2
            float g[8]; int e[8]; float mx = -3.0e38f; const unsigned hmask = 0u - (unsigned)hs;
#pragma unroll
            for (int j = 0; j < 8; ++j) { const unsigned w = m[j] ^ ((m[j] ^ m[8 + j]) & hmask); const int id = 255 - (int)(w & 255u), a = id >> 4, b2 = id & 15;
                g[j] = lsc[base1 + a] + lsc[base2 + b2]; e[j] = lix[base1 + a] * 128 + lix[base2 + b2]; mx = fmaxf(mx, g[j]); }
            mx = fmaxf(mx, __shfl_xor(mx, 32));
            float sum = 0.f;
#pragma unroll
            for (int j = 0; j < 8; ++j) { g[j] = __expf(g[j] - mx); sum += g[j]; }
            sum += __shfl_xor(sum, 32);
            const float inv = 1.0f / sum;
            unsigned short* ep = eid + (size_t)tt * 128 + h * 16 + 8 * hs; float* gp = gate + (size_t)tt * 128 + h * 16 + 8 * hs;
            *(u32x4*)ep = (u32x4){(unsigned)e[0] | ((unsigned)e[1] << 16), (unsigned)e[2] | ((unsigned)e[3] << 16), (unsigned)e[4] | ((unsigned)e[5] << 16), (unsigned)e[6] | ((unsigned)e[7] << 16)};
            *(f32x4*)gp = (f32x4){g[0] * inv, g[1] * inv, g[2] * inv, g[3] * inv}; *(f32x4*)(gp + 4) = (f32x4){g[4] * inv, g[5] * inv, g[6] * inv, g[7] * inv};
        }
        LDS_WAIT();
    }
}
typedef float f32x2 __attribute__((ext_vector_type(2)));
constexpr size_t WS_U8 = WS_R2, WS_V8 = WS_R2 + 16 * MiB, WS_SU = WS_R2 + 32 * MiB, WS_SV = WS_SU + 65536;
__device__ __forceinline__ void convert_tables(const Params& P, int lane, int gw, int NGW) {
    const float* utab = ARG(u_tab); const float* vtab = ARG(v_tab);
    for (int rb = gw * 4; rb < 32768; rb += NGW * 4) {
        const bool isv = rb >= 16384; const int row0 = rb & 16383;
        const float* src = (isv ? vtab : utab) + (size_t)row0 * DM;
        f32x4 v[4][4]; float am[4];
#pragma unroll
        for (int i = 0; i < 4; ++i) { am[i] = 0.f;
#pragma unroll
            for (int j = 0; j < 4; ++j) { v[i][j] = __builtin_nontemporal_load((const f32x4*)(src + (size_t)i * DM + 4 * lane + 256 * j)); am[i] = fmaxf(am[i], fmaxf(fmaxf(fabsf(v[i][j][0]), fabsf(v[i][j][1])), fmaxf(fabsf(v[i][j][2]), fabsf(v[i][j][3])))); } }
#pragma unroll
        for (int o = 1; o < 64; o <<= 1) {
#pragma unroll
            for (int i = 0; i < 4; ++i) am[i] = fmaxf(am[i], __shfl_xor(am[i], o)); }
#pragma unroll
        for (int i = 0; i < 4; ++i) {
            float sc = 1.0f;
            if (am[i] > 0.f) sc = __uint_as_float(__float_as_uint(448.0f / am[i]) & 0x7F800000u);
            sc = fminf(fmaxf(sc, 1.0e-30f), 1.0e30f);
            u32x4 w;
#pragma unroll
            for (int j = 0; j < 4; ++j) { int p = 0; p = __builtin_amdgcn_cvt_pk_fp8_f32(v[i][j][0] * sc, v[i][j][1] * sc, p, false); p = __builtin_amdgcn_cvt_pk_fp8_f32(v[i][j][2] * sc, v[i][j][3] * sc, p, true); w[j] = (unsigned)p; }
#pragma unroll
            for (int j = 0; j < 4; ++j) *(unsigned*)(P.ws + (isv ? WS_V8 : WS_U8) + (size_t)(2 * j + (lane >> 5)) * (2 * MiB) + (size_t)(row0 + i) * 128 + ((4 * lane) & 127)) = w[j];
            if (lane == 0) ((float*)(P.ws + WS_SU))[2 * (row0 + i) + (isv ? 1 : 0)] = 1.0f / sc;
        }
    }
}
#define DPPF(v, ctrl) __uint_as_float((unsigned)__builtin_amdgcn_update_dpp(0, (int)__float_as_uint(v), (ctrl), 0xf, 0xf, true))
#define PEER_EIDS() const u32x4 ea_ = *(const u32x4*)(eid + (size_t)t * 128 + g * 16), eb_ = *(const u32x4*)(eid + (size_t)t * 128 + g * 16 + 8); \
        const unsigned ew[8] = {ea_.x, ea_.y, ea_.z, ea_.w, eb_.x, eb_.y, eb_.z, eb_.w}; int e0 = 0, e1 = 0; \
        _Pragma("unroll") for (int i = 0; i < 16; ++i) { const int ei = (int)((i & 1) ? (ew[i >> 1] >> 16) : (ew[i >> 1] & 0xffffu)); if (i < 8) e0 = ((i & 7) == p) ? ei : e0; else e1 = ((i & 7) == p) ? ei : e1; }
#define PEER_EI(i) ((size_t)(((i) & 1) ? (ew[(i) >> 1] >> 16) : (ew[(i) >> 1] & 0xffffu)))
__device__ __forceinline__ void peer_a(const Params& P, int lane, int x, int wx, int NW) {
    const unsigned char* u8 = P.ws + WS_U8 + (size_t)x * (2 * MiB); const float* su = (const float*)(P.ws + WS_SU);
    const unsigned short* eid = (const unsigned short*)(P.ws + WS_EID); const bf16_t* n2b = (const bf16_t*)(P.ws + WS_R1); float* part = (float*)(P.ws + WS_PART);
    const int g = lane >> 3, p = lane & 7;
    for (int t = wx; t < T_ALL; t += NW) {
        const u32x4 na = *(const u32x4*)(n2b + (size_t)t * DM + x * 128 + p * 16), nb = *(const u32x4*)(n2b + (size_t)t * DM + x * 128 + p * 16 + 8);
        const unsigned nw[8] = {na.x, na.y, na.z, na.w, nb.x, nb.y, nb.z, nb.w}; f32x2 n2[8];
#pragma unroll
        for (int k = 0; k < 8; ++k) n2[k] = (f32x2){bf_lo(nw[k]), bf_hi(nw[k])};
        PEER_EIDS();
        u32x4 ur[16];
#pragma unroll
        for (int i = 0; i < 16; ++i) ur[i] = *(const u32x4*)(u8 + PEER_EI(i) * 128 + p * 16);
        float k0 = 0.f, k1 = 0.f;
#pragma unroll
        for (int i = 0; i < 16; ++i) { f32x2 dp = (f32x2){0.f, 0.f};
#pragma unroll
            for (int k = 0; k < 4; ++k) { const f32x2 lo = __builtin_amdgcn_cvt_pk_f32_fp8((int)ur[i][k], false), hi = __builtin_amdgcn_cvt_pk_f32_fp8((int)ur[i][k], true); dp += lo * n2[2 * k]; dp += hi * n2[2 * k + 1]; }
            float d = dp.x + dp.y; d += DPPF(d, 0xB1); d += DPPF(d, 0x4E); d += DPPF(d, 0x141);
            if (i & 1) k1 = ((i >> 1) == p) ? d : k1; else k0 = ((i >> 1) == p) ? d : k0; }
        *((unsigned*)part + ((size_t)t * 8 + x) * 64 + g * 8 + p) = cvt_pk_bf16(k0, k1);
    }
}
__device__ __forceinline__ void peer_a2(const Params& P, int lane, int gw, int NGW) {
    const float* part = (const float*)(P.ws + WS_PART); const float* gate = (const float*)(P.ws + WS_GATE); const float* sv = (const float*)(P.ws + WS_SV); const float* su = (const float*)(P.ws + WS_SU);
    const unsigned short* eid = (const unsigned short*)(P.ws + WS_EID); float* cfo = (float*)(P.ws + WS_CF);
    const WaveItems wi(T_ALL, gw, NGW);
    for (int k_ = 0; k_ < wi.nk; ++k_) { const int t = wi.item(k_);
        float d0 = 0.f, d1 = 0.f;
#pragma unroll
        for (int xx = 0; xx < 8; ++xx) { const unsigned w = ((const unsigned*)part)[((size_t)t * 8 + xx) * 64 + lane]; d0 += bf_lo(w); d1 += bf_hi(w); }
        const unsigned ew = ((const unsigned*)eid)[(size_t)t * 64 + lane]; const int ea = (int)(ew & 0xffffu), eb = (int)(ew >> 16); const f32x2 sa = *(const f32x2*)(su + 2 * ea), sb = *(const f32x2*)(su + 2 * eb); const float s0 = sa.y, s1 = sb.y;
        d0 *= sa.x; d1 *= sb.x;
        const f32x2 gg = *(const f32x2*)(gate + (size_t)t * 128 + 2 * lane);
        *(f32x2*)(cfo + (size_t)t * 128 + 2 * lane) = (f32x2){gg.x * 0.5f * d0 * (1.0f + erff(d0 * 0.70710678118654752f)) * s0, gg.y * 0.5f * d1 * (1.0f + erff(d1 * 0.70710678118654752f)) * s1};
    }
}
__device__ __forceinline__ void peer_b(const Params& P, LAS float* cfbuf, int lane, int x, int wx, int NW) {
    const unsigned char* v8 = P.ws + WS_V8 + (size_t)x * (2 * MiB); const float* sv = (const float*)(P.ws + WS_SV);
    const unsigned short* eid = (const unsigned short*)(P.ws + WS_EID); const float* cfi = (const float*)(P.ws + WS_CF);
    const float* mod = (const float*)(P.ws + WS_MOD); float* sumsq = (float*)(P.ws + WS_SUMSQ);
    const int g = lane >> 3, p = lane & 7;
    for (int t = wx; t < T_ALL; t += NW) {
        PEER_EIDS();
        u32x4 vr[16];
#pragma unroll
        for (int i = 0; i < 16; ++i) vr[i] = *(const u32x4*)(v8 + PEER_EI(i) * 128 + p * 16);
        const float cf0 = cfi[(size_t)t * 128 + g * 16 + p], cf1 = cfi[(size_t)t * 128 + g * 16 + 8 + p];
        cfbuf[g * 16 + p] = cf0; cfbuf[g * 16 + 8 + p] = cf1;
        asm volatile("s_waitcnt lgkmcnt(0)" ::: "memory");
        f32x4 cfr[4];
#pragma unroll
        for (int k = 0; k < 4; ++k) cfr[k] = *(const LAS f32x4*)(cfbuf + g * 16 + 4 * k);
        asm volatile("s_waitcnt lgkmcnt(0)" ::: "memory");
        f32x2 acc[8];
#pragma unroll
        for (int k = 0; k < 8; ++k) acc[k] = (f32x2){0.f, 0.f};
#pragma unroll
        for (int i = 0; i < 16; ++i) { const float cf = cfr[i >> 2][i & 3]; const f32x2 cfv = (f32x2){cf, cf};
#pragma unroll
            for (int k = 0; k < 4; ++k) { const f32x2 lo = __builtin_amdgcn_cvt_pk_f32_fp8((int)vr[i][k], false), hi = __builtin_amdgcn_cvt_pk_f32_fp8((int)vr[i][k], true); acc[2 * k] += cfv * lo; acc[2 * k + 1] += cfv * hi; } }
        f32x2 r4[4], r2[2], r1;
#pragma unroll
        for (int k = 0; k < 4; ++k) { const f32x2 keep = (lane & 8) ? acc[k + 4] : acc[k], send = (lane & 8) ? acc[k] : acc[k + 4]; r4[k] = keep + (f32x2){DPPF(send.x, 0x128), DPPF(send.y, 0x128)}; }
#pragma unroll
        for (int k = 0; k < 2; ++k) { const f32x2 keep = (lane & 16) ? r4[k + 2] : r4[k], send = (lane & 16) ? r4[k] : r4[k + 2]; r2[k] = keep + (f32x2){__shfl_xor(send.x, 16), __shfl_xor(send.y, 16)}; }
        { const f32x2 keep = (lane & 32) ? r2[1] : r2[0], send = (lane & 32) ? r2[0] : r2[1]; r1 = keep + (f32x2){__shfl_xor(send.x, 32), __shfl_xor(send.y, 32)}; }
        const int col = x * 128 + p * 16 + 2 * (((lane >> 3) & 1) * 4 + ((lane >> 4) & 1) * 2 + ((lane >> 5) & 1));
        *(unsigned*)((bf16_t*)(P.ws + WS_R1) + (size_t)t * DM + col) = cvt_pk_bf16(r1.x, r1.y);
    }
}
__device__ __forceinline__ void peer_c(const Params& P, int lane, int gw, int NGW) {
    const float* mod = (const float*)(P.ws + WS_MOD); const bf16_t* po = (const bf16_t*)(P.ws + WS_R1); const float* gfin = ARG(g_final);
    const WaveItems wi(T_ALL, gw, NGW);
    for (int k_ = 0; k_ < wi.nk; ++k_) { const int t = wi.item(k_);
        float* xr = P.out + (size_t)t * DM; const float* gt = mod + (size_t)modrow(t) * MODW + 5120;
        f32x4 x2[4]; float ss = 0.f;
#pragma unroll
        for (int j = 0; j < 4; ++j) { const int c0 = 4 * lane + 256 * j; const u32x2 d = __builtin_nontemporal_load((const u32x2*)(po + (size_t)t * DM + c0));
            x2[j] = __builtin_nontemporal_load((const f32x4*)(xr + c0)) + *(const f32x4*)(gt + c0) * (f32x4){bf_lo(d.x), bf_hi(d.x), bf_lo(d.y), bf_hi(d.y)};
            ss += (x2[j][0] * x2[j][0] + x2[j][1] * x2[j][1]) + (x2[j][2] * x2[j][2] + x2[j][3] * x2[j][3]); }
        const float rstd = rsqrtf(wave_sum(ss) * (1.0f / DM) + EPS);
#pragma unroll
        for (int j = 0; j < 4; ++j) { const int c0 = 4 * lane + 256 * j; __builtin_nontemporal_store(x2[j] * rstd * *(const f32x4*)(gfin + c0), (f32x4*)(xr + c0)); }
    }
}
template <int NF> __device__ __forceinline__ void wave_mma(const bf16_t* Ap, const bf16_t* const (&Bp)[NF], int K, f32x4 (&acc)[NF]) {
#pragma unroll 8
    for (int k = 0; k < K; k += 32) { const bf16x8 a = *(const bf16x8*)(Ap + k);
#pragma unroll
        for (int f = 0; f < NF; ++f) { const bf16x8 b = *(const bf16x8*)(Bp[f] + k); acc[f] = __builtin_amdgcn_mfma_f32_16x16x32_bf16(b, a, acc[f], 0, 0, 0); } }
}
__device__ __forceinline__ u32x2 pack4(f32x4 v) { u32x2 o; o.x = cvt_pk_bf16(v[0], v[1]); o.y = cvt_pk_bf16(v[2], v[3]); return o; }
__device__ __forceinline__ void sample_z(const Params& P, int lane, int gw, int NGW) {
    const int fr = lane & 15, fq = lane >> 4; unsigned char* ws = P.ws;
    const bf16_t* A = (const bf16_t*)(ws + WS_R1) + (size_t)T_P * 1024; const bf16_t* W = (const bf16_t*)(ws + WS_WINT);
    for (int it = gw; it < 1792; it += NGW) {
        if (it < 256) { const int cf = it >> 3, rf = it & 7, ch0 = 16 * cf; const size_t r = (size_t)T_P + 16 * rf + fr;
            const bf16_t* Ap = A + (size_t)(16 * rf + fr) * 1024 + 8 * fq;
            const bf16_t* const Bp[2] = {W + (size_t)(winmap(ch0) + fr) * 1024 + 8 * fq, W + (size_t)(winmap(512 + ch0) + fr) * 1024 + 8 * fq};
            f32x4 acc[2] = {(f32x4){0.f, 0.f, 0.f, 0.f}, (f32x4){0.f, 0.f, 0.f, 0.f}};
            wave_mma<2>(Ap, Bp, 1024, acc);
            f32x4 o;
#pragma unroll
            for (int e = 0; e < 4; ++e) o[e] = acc[0][e] * sigm(acc[1][e]);
            *(f32x4*)((float*)(ws + WS_R3) + r * 512 + ch0 + 4 * fq) = o;
        } else { const int it2 = it - 256, cf = it2 >> 3, rf = it2 & 7, n0 = 1024 + 16 * cf; const size_t r = (size_t)T_P + 16 * rf + fr;
            const bf16_t* Ap = A + (size_t)(16 * rf + fr) * 1024 + 8 * fq;
            const bf16_t* const Bp[1] = {W + (size_t)(n0 + fr) * 1024 + 8 * fq};
            f32x4 acc[1] = {(f32x4){0.f, 0.f, 0.f, 0.f}};
            wave_mma<1>(Ap, Bp, 1024, acc);
            if (n0 < 1536) *(u32x2*)((bf16_t*)(ws + WS_R4) + r * 512 + (n0 - 1024) + 4 * fq) = pack4(acc[0]);
            else if (n0 < 2048) *(f32x4*)((float*)(ws + WS_R5) + r * 512 + (n0 - 1536) + 4 * fq) = acc[0];
            else { f32x4 sg;
#pragma unroll
                for (int e = 0; e < 4; ++e) sg[e] = sigm(acc[0][e]);
                bf16_t* gdst = (bf16_t*)(ws + WS_R2) + (n0 < 3072 ? (size_t)0 : (size_t)MP * 1024);
                *(u32x2*)(gdst + r * 1024 + ((n0 - 2048) & 1023) + 4 * fq) = pack4(sg); }
        }
    }
}
__device__ __forceinline__ void sample_m(const Params& P, int lane, int gw, int NGW) {
    const int fr = lane & 15, fq = lane >> 4; unsigned char* ws = P.ws;
    const bf16_t* A = (const bf16_t*)(ws + WS_R1) + (size_t)T_P * 1024; const bf16_t* W = (const bf16_t*)(ws + WS_WCGT);
    const bf16_t* ga = (const bf16_t*)(ws + WS_R2); const bf16_t* gb = ga + (size_t)MP * 1024; bf16_t* mb = (bf16_t*)(ws + WS_R3);
    for (int it = gw; it < 512; it += NGW) { const int cf = it >> 3, rf = it & 7, n0 = 16 * cf; const size_t r = (size_t)T_P + 16 * rf + fr;
        const bf16_t* Ap = A + (size_t)(16 * rf + fr) * 1024 + 8 * fq;
        const bf16_t* const Bp[1] = {W + (size_t)(n0 + fr) * 1024 + 8 * fq};
        f32x4 acc[1] = {(f32x4){0.f, 0.f, 0.f, 0.f}};
        wave_mma<1>(Ap, Bp, 512, acc);
        const u32x2 a2 = *(const u32x2*)(ga + r * 1024 + n0 + 4 * fq), b2 = *(const u32x2*)(gb + r * 1024 + n0 + 4 * fq);
        const f32x4 gav = (f32x4){bf_lo(a2.x), bf_hi(a2.x), bf_lo(a2.y), bf_hi(a2.y)}, gbv = (f32x4){bf_lo(b2.x), bf_hi(b2.x), bf_lo(b2.y), bf_hi(b2.y)};
#pragma unroll
        for (int e = 0; e < 4; ++e) acc[0][e] *= gav[e] * __builtin_amdgcn_rcpf(fmaxf(gbv[e], 1e-30f));
        const bf16_t* Ap2 = Ap + 512; const bf16_t* const Bp2[1] = {Bp[0] + 512};
        wave_mma<1>(Ap2, Bp2, 512, acc);
        *(u32x2*)(mb + r * 1024 + n0 + 4 * fq) = pack4(acc[0] * gbv);
    }
}
__device__ __forceinline__ void sample_x1(const Params& P, int lane, int gw, int NGW) {
    const int fr = lane & 15, fq = lane >> 4; unsigned char* ws = P.ws;
    const bf16_t* A = (const bf16_t*)(ws + WS_R3) + (size_t)T_P * 1024; const bf16_t* W = (const bf16_t*)(ws + WS_WOUTT);
    const float* xs = ARG(x_sample); const float* mod = (const float*)(ws + WS_MOD);
    for (int it = gw; it < 512; it += NGW) { const int cf = it >> 3, rf = it & 7, n0 = 16 * cf, i = 16 * rf + fr;
        const bf16_t* Ap = A + (size_t)i * 1024 + 8 * fq;
        const bf16_t* const Bp[1] = {W + (size_t)(n0 + fr) * 1024 + 8 * fq};
        f32x4 acc[1] = {(f32x4){0.f, 0.f, 0.f, 0.f}};
        wave_mma<1>(Ap, Bp, 1024, acc);
        const int c = n0 + 4 * fq;
        *(f32x4*)(P.out + ((size_t)T_P + i) * DM + c) = *(const f32x4*)(xs + (size_t)i * DM + c) + *(const f32x4*)(mod + (size_t)(8 + i) * MODW + 2048 + c) * acc[0];
    }
}
__device__ __forceinline__ void sample_s(const Params& P, int lane, int gw, int NGW) {
    const int fr = lane & 15, fq = lane >> 4; unsigned char* ws = P.ws;
    const bf16_t* A = (const bf16_t*)(ws + WS_R1) + (size_t)T_P * 1024; const bf16_t* W = (const bf16_t*)(ws + WS_WQT); float* sc = (float*)(ws + WS_R3);
    for (int it = gw; it < 1024; it += NGW) { const int cf = it >> 3, rf = it & 7, n0 = 16 * cf, h = n0 >> 8, half = (n0 >> 7) & 1, j0 = (n0 & 127) + 4 * fq;
        const bf16_t* Ap = A + (size_t)(16 * rf + fr) * 1024 + 8 * fq;
        const bf16_t* const Bp[1] = {W + (size_t)(n0 + fr) * 1024 + 8 * fq};
        f32x4 acc[1] = {(f32x4){0.f, 0.f, 0.f, 0.f}};
        wave_mma<1>(Ap, Bp, 1024, acc);
        *(f32x4*)(sc + (size_t)(512 + h) * 65536 + (size_t)(j0 >> 2) * 2048 + half * 1024 + (16 * rf + fr) * 4) = acc[0];
    }
}
#define XB_TMO      128
#define XB_XCNT(j)  (256  + 64 * (j))
#define XB_XSUB(j)  (1280 + 64 * (j))
#define XB_XGEN(j)  (2304 + 64 * (j))
#define XB_TOP      3328
#define XB_TOPGEN   3392
#define XCD_BAR_WORDS 3456
#define XB_SPIN_CAP (1u << 18)

__device__ __forceinline__ unsigned xb_ld(unsigned* p)              { return __hip_atomic_load(p, __ATOMIC_RELAXED, __HIP_MEMORY_SCOPE_AGENT); }
__device__ __forceinline__ unsigned xb_add(unsigned* p, unsigned v) { return __hip_atomic_fetch_add(p, v, __ATOMIC_RELAXED, __HIP_MEMORY_SCOPE_AGENT); }
__device__ __forceinline__ unsigned xb_xcc_id() { return (unsigned)__builtin_amdgcn_s_getreg((3 << 11) | 20) & 0xFu; }
#define XB_SPIN(cond, bar) do { unsigned _sp = 0; while (cond) { __builtin_amdgcn_s_sleep(1); \
    if ((++_sp & 255u) == 0u) { if (xb_ld(&(bar)[XB_TMO])) break; if (_sp > XB_SPIN_CAP) { atomicAdd(&(bar)[XB_TMO], 1u); break; } } } } while (0)

struct XcdBarrier {
    unsigned* bar; unsigned x;
    volatile LAS unsigned* st;
};

__device__ __forceinline__ XcdBarrier xcd_barrier_post(unsigned* bar, volatile LAS unsigned* st) {
    XcdBarrier b; b.bar = bar; b.x = xb_xcc_id(); b.st = st;
    if (threadIdx.x == 0) (void)xb_add(&bar[XB_XCNT(b.x)], 1u);
    return b;
}
__device__ __forceinline__ void xcd_barrier_complete(unsigned* bar, unsigned x, unsigned& nloc, unsigned& nx) {
    const unsigned G = gridDim.x * gridDim.y * gridDim.z;
    unsigned sum, cnt, mine, sp = 0u;
    for (;;) {
        sum = 0u; cnt = 0u; mine = 0u;
#pragma unroll
        for (unsigned j = 0; j < 16; ++j) { const unsigned c = xb_ld(&bar[XB_XCNT(j)]); sum += c; cnt += (c > 0u) ? 1u : 0u; mine = (j == x) ? c : mine; }
        if (sum == G) break;
        __builtin_amdgcn_s_sleep(1);
        if ((++sp & 255u) == 0u) { if (xb_ld(&bar[XB_TMO])) break; if (sp > XB_SPIN_CAP) { atomicAdd(&bar[XB_TMO], 1u); break; } }
    }
    nloc = mine > 0u ? mine : 1u; nx = cnt > 0u ? cnt : 1u;
}

__device__ __forceinline__ void xcd_barrier(const XcdBarrier& b) {
    asm volatile("s_waitcnt vmcnt(0)" ::: "memory");
    __syncthreads();
    if (threadIdx.x == 0) {
        unsigned* bar = b.bar;
        __builtin_amdgcn_s_waitcnt(0);
        unsigned nloc = b.st[0], nx = b.st[1];
        if (nloc == 0u) { xcd_barrier_complete(bar, b.x, nloc, nx); b.st[0] = nloc; b.st[1] = nx; }
        const unsigned old = xb_add(&bar[XB_XSUB(b.x)], 1u);
        const unsigned gen = old / nloc;
        if (old + 1u == (gen + 1u) * nloc) {
            __builtin_amdgcn_fence(__ATOMIC_RELEASE, "agent");
            asm volatile("s_waitcnt vmcnt(0)" ::: "memory");
            const unsigned og = xb_add(&bar[XB_TOP], 1u);
            const unsigned tg = og / nx;
            if (og + 1u == (tg + 1u) * nx) xb_add(&bar[XB_TOPGEN], 1u);
            else XB_SPIN(xb_ld(&bar[XB_TOPGEN]) == tg, bar);
            __builtin_amdgcn_fence(__ATOMIC_ACQUIRE, "agent");
            xb_add(&bar[XB_XGEN(b.x)], 1u);
            asm volatile("s_waitcnt vmcnt(0)" ::: "memory");
        } else {
            XB_SPIN(xb_ld(&bar[XB_XGEN(b.x)]) == gen, bar);
            __builtin_amdgcn_fence(__ATOMIC_ACQUIRE, "agent");
            asm volatile("s_waitcnt vmcnt(0)" ::: "memory");
        }
    }
    __syncthreads();
}


__global__ void __launch_bounds__(512) mega(Params P) {
    extern __shared__ __attribute__((aligned(16))) unsigned char smem[];
    PG8_LAS unsigned char* lds = (PG8_LAS unsigned char*)smem;
    cg::grid_group grid = cg::this_grid();
    const int tid = threadIdx.x, lane = tid & 63, wave = __builtin_amdgcn_readfirstlane(tid >> 6), G = gridDim.x, gw = blockIdx.x * 8 + wave, NGW = G * 8;
    unsigned char* ws = P.ws;
    const int lo = P.ph_lo, hi = P.ph_hi;
    if (lo > hi) grid.sync();
    volatile LAS unsigned* xst = (volatile LAS unsigned*)(lds + LDS_MAIN);
    if (tid == 0) { xst[0] = 0u; xst[1] = 0u; const unsigned xc = xb_xcc_id() & 7u; xst[2] = xc; xst[3] = xb_add((unsigned*)(ws + WS_CNT2) + 64 * xc, 1u); }
    __syncthreads();
    (void)xcd_barrier_post((unsigned*)ws, xst);
#define IN(k) (lo <= (k) && (k) < hi && PHON(k))
#define SEAM(k) do { if (lo <= (k) && (k) + 1 < hi) { XcdBarrier xb_; xb_.bar = (unsigned*)ws; xb_.x = xb_xcc_id(); xb_.st = xst; xcd_barrier(xb_); } } while (0)
    if (IN(0)) for (int rep_ = 0; rep_ < REPS(0); ++rep_) phase0<0>(P, lds, lane, wave, gw, NGW);
    SEAM(0);
    if (IN(1)) for (int rep_ = 0; rep_ < REPS(1); ++rep_) {
        pg8::Gemm g = pg8::mk_gemm((const bf16_t*)(ws + WS_CS), (const bf16_t*)(ws + WS_R3), 256, MODW, 512, 1024); pg8::KSplitOrder S; S.init(MODW, 2, G, (int)blockIdx.x);
        constexpr int NU = 2 * (MODW / 256), NW_ = 32;
        pg8::Gemm gw_ = pg8::mk_gemm((const bf16_t*)(ws + WS_KBLK), (const bf16_t*)(ws + WS_WQN), 2048, 1024, 256, 256);
        gw_.ldb = 2048; gw_.a_tile = 0; gw_.b_tile = (size_t)256 * 2048 * 2; gw_.b_pm = 512;
        const bool split_ = G >= NU + NW_ + 8; const int b_ = (int)blockIdx.x;
        if (!split_ || b_ < NU) { EpiMod E{(float*)(ws + WS_MODP), nullptr}; pg8::gemm_phase<EpiMod, pg8::KSplitOrder>(lds, g, S, E); }
        if (!split_ || (b_ >= NU && b_ < NU + NW_)) { pg8::StaticOrder S2; S2.init(2048, 1024, G, split_ ? b_ - NU : b_); EpiW E2{(bf16_t*)(ws + WS_WQT)}; pg8::gemm_phase<EpiW, pg8::StaticOrder>(lds, gw_, S2, E2); }
        if (!split_ || b_ >= NU + NW_) phase0<1>(P, lds, lane, wave, split_ ? gw - (NU + NW_) * 8 : gw, split_ ? NGW - (NU + NW_) * 8 : NGW);
    }
    SEAM(1);
    if (IN(2)) for (int rep_ = 0; rep_ < REPS(2); ++rep_) {
        {
            const float* mp = (const float*)(ws + WS_MODP); float* mo = (float*)(ws + WS_MOD); const float* bada = ARG(b_ada);
            for (int q = gw * 64 + lane; q < 136 * 1024; q += NGW * 64) { const int r = q >> 10, c = 2048 + 4 * (q & 1023); const size_t o = (size_t)r * MODW + c;
                *(f32x4*)(mo + o) = *(const f32x4*)(mp + o) + *(const f32x4*)(mp + MODP_STRIDE + o) + *(const f32x4*)(bada + c); } }
        norm_rows<false>(P, (bf16_t*)(ws + WS_R1), lane, gw, NGW); }
    SEAM(2);
    if (IN(3)) for (int rep_ = 0; rep_ < REPS(3); ++rep_) {
        sample_z(P, lane, gw, NGW);
        pg8::Gemm g = pg8::mk_gemm((const bf16_t*)(ws + WS_R1), (const bf16_t*)(ws + WS_WINT), T_P, 4096, 1024, 1024); pg8::StaticOrder S; S.init(T_P, 4096, G, (int)blockIdx.x);
        EpiZ E{(float*)(ws + WS_R3), (bf16_t*)(ws + WS_R4), (float*)(ws + WS_R5), (bf16_t*)(ws + WS_R2), (bf16_t*)(ws + WS_R2) + (size_t)MP * 1024};
        pg8::gemm_phase<EpiZ, pg8::StaticOrder>(lds, g, S, E);
    }
    SEAM(3);
    if (IN(4)) for (int rep_ = 0; rep_ < REPS(4); ++rep_) {
        for (int it = blockIdx.x; it < 256; it += G) { conv_tile(P, lds, it >> 1, it & 1, tid, lane, wave); gmlp_tile(P, lds, it >> 1, it & 1, lane, wave); }
        for (int s = (int)blockIdx.x; s < 256; s += G) { if ((s & 1) == 0) sample_conv_block(P, lds, s >> 1, lane, wave); else if (wave == 0) sample_item(P, s, lane); }
    }
    SEAM(4);
    if (IN(5)) for (int rep_ = 0; rep_ < REPS(5); ++rep_) {
        sample_m(P, lane, gw, NGW);
        pg8::Gemm g = pg8::mk_gemm((const bf16_t*)(ws + WS_R1), (const bf16_t*)(ws + WS_WCGT), T_P, 1024, 512, 1024); pg8::SplitOrder S; S.init(T_P, 1024, G, (int)blockIdx.x);
        EpiM E{(const bf16_t*)(ws + WS_R2), (const bf16_t*)(ws + WS_R2) + (size_t)MP * 1024, (bf16_t*)(ws + WS_R3)};
        pg8::gemm_phase<EpiM, pg8::SplitOrder>(lds, g, S, E);
    }
    SEAM(5);
    if (IN(6)) for (int rep_ = 0; rep_ < REPS(6); ++rep_) {
        sample_x1(P, lane, gw, NGW);
        pg8::Gemm g = pg8::mk_gemm((const bf16_t*)(ws + WS_R3), (const bf16_t*)(ws + WS_WOUTT), T_P, 1024, 1024, 1024); pg8::StaticOrder S; S.init(T_P, 1024, G, (int)blockIdx.x);
        EpiX1 E{ARG(x_prompt), ARG(x_sample), (const float*)(ws + WS_MOD), P.out}; pg8::gemm_phase<EpiX1, pg8::StaticOrder>(lds, g, S, E);
    }
    SEAM(6);
    if (IN(7)) for (int rep_ = 0; rep_ < REPS(7); ++rep_) norm_rows<true>(P, (bf16_t*)(ws + WS_R1), lane, gw, NGW);
    SEAM(7);
    if (IN(8)) for (int rep_ = 0; rep_ < REPS(8); ++rep_) {
        if (blockIdx.x & 1) convert_tables(P, lane, gw, NGW);
        sample_s(P, lane, gw, NGW);
        pg8::Gemm g = pg8::mk_gemm((const bf16_t*)(ws + WS_R1), (const bf16_t*)(ws + WS_WQT), T_P, 2048, 1024, 1024); pg8::StaticOrder S; S.init(T_P, 2048, G, (int)blockIdx.x);
        EpiS2 E{(float*)(ws + WS_R3)}; pg8::gemm_phase<EpiS2, pg8::StaticOrder>(lds, g, S, E);
        if (!(blockIdx.x & 1)) convert_tables(P, lane, gw, NGW);
    }
    SEAM(8);
    if (IN(10)) for (int rep_ = 0; rep_ < REPS(10); ++rep_) topk_phase(P, lds, lane, wave, gw, NGW);
    SEAM(10);
    int px = (int)xst[2], prank = (int)xst[3], pn = 1;
    if (IN(11) || IN(13)) { unsigned cn[8]; bool ok = true;
#pragma unroll
        for (int j = 0; j < 8; ++j) { cn[j] = xb_ld((unsigned*)(ws + WS_CNT2) + 64 * j); ok = ok && cn[j] > 0u; }
        if (ok) { pn = (int)cn[0];
#pragma unroll
            for (int j = 1; j < 8; ++j) pn = (px == j) ? (int)cn[j] : pn; }
        else { px = (int)blockIdx.x & 7; prank = (int)blockIdx.x >> 3; pn = (G + 7 - px) / 8; } }
    if (IN(11)) peer_a(P, lane, px, prank * 8 + wave, pn * 8);
    SEAM(11);
    if (IN(12)) peer_a2(P, lane, gw, NGW);
    SEAM(12);
    if (IN(13)) peer_b(P, (LAS float*)(lds + wave * 512), lane, px, prank * 8 + wave, pn * 8);
    SEAM(13);
    if (IN(14)) peer_c(P, lane, gw, NGW);
#undef IN
#undef SEAM
}

extern "C" void kernel_launch(void* const* d_in, const int* in_sizes, int n_in, void* d_out, int out_size, void* d_ws, size_t ws_size, hipStream_t stream) {
    static int grid = 0;
    if (grid == 0) {
        if (n_in != 27 || ws_size < WS_END) { fprintf(stderr, "kernel_launch: need 27 inputs and >= %zu bytes of workspace; got %d, %zu\n", (size_t)WS_END, n_in, ws_size); grid = -1; return; }
        int dev = 0, cus = 0, per_cu = 0;
        (void)hipGetDevice(&dev); (void)hipDeviceGetAttribute(&cus, hipDeviceAttributeMultiprocessorCount, dev);
        if (hipFuncSetAttribute((const void*)mega, hipFuncAttributeMaxDynamicSharedMemorySize, LDS_BYTES) != hipSuccess) { fprintf(stderr, "kernel_launch: hipFuncSetAttribute failed\n"); grid = -1; return; }
        if (hipOccupancyMaxActiveBlocksPerMultiprocessor(&per_cu, (const void*)mega, 512, LDS_BYTES) != hipSuccess || per_cu < 1) { fprintf(stderr, "kernel_launch: occupancy query says %d blocks per CU\n", per_cu); (void)hipGetLastError(); grid = -1; return; }
        grid = cus;
    }
    if (grid < 0) return;
    if (hipMemsetAsync(d_ws, 0, WS_CTL_BYTES, stream) != hipSuccess) { fprintf(stderr, "kernel_launch: memset of the barrier words failed\n"); return; }
    Params p{};
    for (int i = 0; i < 27; ++i) p.in[i] = (const float*)d_in[i];
    p.out = (float*)d_out; p.ws = (unsigned char*)d_ws;
#if defined(MK_MULTI)
    for (int ph = 0; ph < NPH; ++ph) { p.ph_lo = ph; p.ph_hi = ph + 1; void* args[] = {&p};
        hipError_t e = hipLaunchCooperativeKernel((const void*)mega, dim3(grid), dim3(512), args, LDS_BYTES, stream);
        if (e != hipSuccess) fprintf(stderr, "launch failed: %s\n", hipGetErrorString(e)); }
#else
    p.ph_lo = 0; p.ph_hi = NPH; void* args[] = {&p};
    hipError_t e = hipLaunchCooperativeKernel((const void*)mega, dim3(grid), dim3(512), args, LDS_BYTES, stream);
    if (e != hipSuccess) fprintf(stderr, "cooperative launch failed: %s (grid %d)\n", hipGetErrorString(e), grid);
#endif
}
```
